# Optimizing an MI355X kernel written in HIP

```python
import jax, jax.numpy as jnp
from jax import lax
import numpy as np

D_MODEL = 1024
BATCH = 16
SEQ = 256
DEPTH = 1
DEC_BATCH = 2
DEC_SEQ = 2048
PAST_LEN = 256

GRID_W = 64
POS_THETA = 10000.0
EPS = 1e-6
N_MOD = 6
A_GROUPS = 4
A_GROUP_DIM = 128
A_WIDTH = A_GROUPS * A_GROUP_DIM
CHUNK_MLP = 128
H_B = 4
DK = 128
DV = 128
QK_WIDTH = H_B * DK
V_WIDTH = H_B * DV
CHUNK_REC = 32
IN_SPLITS = (A_WIDTH, A_WIDTH, QK_WIDTH, QK_WIDTH, QK_WIDTH, V_WIDTH, V_WIDTH, D_MODEL, D_MODEL)
IN_WIDTH = A_WIDTH * 2 + QK_WIDTH * 3 + V_WIDTH * 2 + D_MODEL * 2
PEER_HEADS = 8
N_KEYS = 128
N_EXPERTS = N_KEYS * N_KEYS
PEER_TOPK = 16
PEER_QHALF = 128
PEER_QDIM = 2 * PEER_QHALF
PEER_BLOCK = 128

kernel_name = "hybrid_gmlp_hgrn2_peer_diffusion_step"


def rmsnorm(x, g):
    xf = x.astype(jnp.float32)
    y = xf * lax.rsqrt(jnp.mean(xf * xf, axis=-1, keepdims=True) + EPS)
    return (y * g.astype(jnp.float32)).astype(x.dtype)


def grid_pos_embed(n_tokens):
    rows = n_tokens // GRID_W
    r = jnp.repeat(jnp.arange(rows, dtype=jnp.float32), GRID_W)
    col = jnp.tile(jnp.arange(GRID_W, dtype=jnp.float32), rows)
    quarter = D_MODEL // 4
    omega = 1.0 / (POS_THETA ** (jnp.arange(quarter, dtype=jnp.float32) / quarter))
    ar = r[:, None] * omega
    ac = col[:, None] * omega
    return jnp.concatenate([jnp.sin(ar), jnp.cos(ar), jnp.sin(ac), jnp.cos(ac)], axis=-1)


def adaln(cond, w_ada, b_ada):
    m = jax.nn.silu(cond) @ w_ada + b_ada
    return m.reshape(-1, N_MOD, D_MODEL)


def chunk_gmlp(zu, zv, norm_g, w_s, b_s):
    B, T, _ = zu.shape
    n = T // CHUNK_MLP
    u = jax.nn.gelu(zu)
    v = rmsnorm(jax.nn.gelu(zv), norm_g)
    vc = v.reshape(B, n, CHUNK_MLP, A_GROUPS, A_GROUP_DIM)
    vs = jnp.einsum('gts,bnsgc->bntgc', w_s, vc) + b_s.T[None, None, :, :, None]
    return u * vs.reshape(B, T, A_WIDTH)


def hgrn2_chunk_scan(q, k, v, logf, s0):
    B, H, T, _ = q.shape
    n = T // CHUNK_REC

    def to_chunks(a):
        return a.reshape(B, H, n, CHUNK_REC, a.shape[-1]).transpose(2, 0, 1, 3, 4)

    mask = jnp.tril(jnp.ones((CHUNK_REC, CHUNK_REC), dtype=bool))[:, :, None]

    def step(S, inp):
        qc, kc, vc, lfc = inp
        b = jnp.cumsum(lfc, axis=-2)
        diff = b[..., :, None, :] - b[..., None, :, :]
        decay = jnp.exp(jnp.where(mask, diff, -jnp.inf))
        scores = jnp.einsum('bhtk,bhsk,bhtsk->bhts', qc, kc, decay)
        o = (jnp.einsum('bhts,bhsv->bhtv', scores, vc)
             + jnp.einsum('bhtk,bhkv->bhtv', qc * jnp.exp(b), S))
        b_last = b[..., -1:, :]
        S_new = (jnp.exp(b_last[..., 0, :])[..., None] * S
                 + jnp.einsum('bhsk,bhsv->bhkv', kc * jnp.exp(b_last - b), vc))
        return S_new, o

    s_fin, o = lax.scan(step, s0, (to_chunks(q), to_chunks(k), to_chunks(v), to_chunks(logf)))
    o = o.transpose(1, 2, 0, 3, 4).reshape(B, H, T, v.shape[-1])
    return o, s_fin


def hgrn2_bidir(zq, zf_fw, zf_bw, zi, zg, lb, norm_g, s0):
    B, T, _ = zq.shape

    def heads(a):
        return a.reshape(B, T, H_B, -1).transpose(0, 2, 1, 3).astype(jnp.float32)

    def gates(zf, lb_d):
        f = lb_d + (1.0 - lb_d) * jax.nn.sigmoid(zf.astype(jnp.float32))
        return heads(1.0 - f), heads(jnp.log(f))

    q = heads(zq)
    v = heads(zi)
    k_fw, lf_fw = gates(zf_fw, lb[0])
    k_bw, lf_bw = gates(zf_bw, lb[1])
    o_fw, s_fw = hgrn2_chunk_scan(q, k_fw, v, lf_fw, s0[:, 0])
    flip = lambda a: jnp.flip(a, axis=2)
    o_bw, s_bw = hgrn2_chunk_scan(flip(q), flip(k_bw), flip(v), flip(lf_bw), s0[:, 1])
    o = (o_fw + flip(o_bw)).transpose(0, 2, 1, 3)
    o = rmsnorm(o, norm_g) * jax.nn.silu(zg.reshape(B, T, H_B, DV).astype(jnp.float32))
    return o.reshape(B, T, V_WIDTH).astype(zq.dtype), jnp.stack([s_fw, s_bw], axis=1)


def peer(x, w_q, sub_keys, u_tab, v_tab):
    shp = x.shape
    xt = x.reshape(-1, D_MODEL)
    n_tok = xt.shape[0]
    q = (xt @ w_q).reshape(n_tok, PEER_HEADS, 2, PEER_QHALF)
    s = jnp.einsum('thpc,hpkc->thpk', q, sub_keys).astype(jnp.float32)
    v1, i1 = lax.top_k(s[:, :, 0], PEER_TOPK)
    v2, i2 = lax.top_k(s[:, :, 1], PEER_TOPK)
    cand = (v1[..., :, None] + v2[..., None, :]).reshape(n_tok, PEER_HEADS, PEER_TOPK * PEER_TOPK)
    cand_idx = (i1[..., :, None] * N_KEYS + i2[..., None, :]).reshape(n_tok, PEER_HEADS, PEER_TOPK * PEER_TOPK)
    top_v, top_j = lax.top_k(cand, PEER_TOPK)
    idx = jnp.take_along_axis(cand_idx, top_j, axis=-1).reshape(n_tok, PEER_HEADS * PEER_TOPK)
    g = jax.nn.softmax(top_v, axis=-1).reshape(n_tok, PEER_HEADS * PEER_TOPK).astype(x.dtype)
    nb = n_tok // PEER_BLOCK

    def block(args):
        xb, ib, gb = args
        ue = jnp.take(u_tab, ib, axis=0)
        ve = jnp.take(v_tab, ib, axis=0)
        a = jax.nn.gelu(jnp.einsum('bd,bed->be', xb, ue)) * gb
        return jnp.einsum('be,bed->bd', a, ve)

    out = lax.map(block, (xt.reshape(nb, PEER_BLOCK, D_MODEL),
                          idx.reshape(nb, PEER_BLOCK, -1),
                          g.reshape(nb, PEER_BLOCK, -1)))
    return out.reshape(shp)


def trunk_layer(x, mod, s0, lb, norm1_g, w_in, sgu_norm_g, w_spatial, b_spatial, hgrn_norm_g,
                w_proj_a, w_proj_b, w_out, norm2_g, peer_w_q, peer_sub_keys, peer_u, peer_v):
    shift1, scale1, gate1, shift2, scale2, gate2 = [mod[:, i][:, None, :] for i in range(N_MOD)]
    h = rmsnorm(x, norm1_g) * (1.0 + scale1) + shift1
    z = h @ w_in
    offsets = []
    acc = 0
    for s in IN_SPLITS[:-1]:
        acc += s
        offsets.append(acc)
    zu, zv, zq, zf_fw, zf_bw, zi, zg, za, zb = jnp.split(z, offsets, axis=-1)
    y_a = chunk_gmlp(zu, zv, sgu_norm_g, w_spatial, b_spatial)
    y_b, s_fin = hgrn2_bidir(zq, zf_fw, zf_bw, zi, zg, lb, hgrn_norm_g, s0)
    mix = (jax.nn.sigmoid(za) * (y_a @ w_proj_a) + jax.nn.sigmoid(zb) * (y_b @ w_proj_b)) @ w_out
    x = x + gate1 * mix
    h = rmsnorm(x, norm2_g) * (1.0 + scale2) + shift2
    x = x + gate2 * peer(h, peer_w_q, peer_sub_keys, peer_u, peer_v)
    return x, s_fin


def setup_inputs(seed: int = 0) -> dict:
    key = jax.random.key(seed)
    ks = jax.random.split(key, 24)
    nrm = lambda k, shape, scale: jax.random.normal(k, shape, jnp.float32) * scale
    Dinv = D_MODEL ** -0.5
    return {
        "x_prompt": nrm(ks[0], (BATCH, SEQ, D_MODEL), 1.0),
        "x_sample": nrm(ks[1], (DEC_BATCH, DEC_SEQ, D_MODEL), 1.0),
        "state_hgrn": nrm(ks[2], (DEC_BATCH, DEPTH, 2, H_B, DK, DV), 0.5),
        "c": nrm(ks[3], (DEC_BATCH, D_MODEL), 1.0),
        "c_ctx": nrm(ks[4], (D_MODEL,), 1.0),
        "w_ada": nrm(ks[5], (DEPTH, D_MODEL, N_MOD * D_MODEL), Dinv),
        "b_ada": nrm(ks[6], (DEPTH, N_MOD * D_MODEL), 0.02),
        "norm1_g": 1.0 + nrm(ks[7], (DEPTH, D_MODEL), 0.02),
        "w_in": nrm(ks[8], (DEPTH, D_MODEL, IN_WIDTH), Dinv),
        "sgu_norm_g": 1.0 + nrm(ks[9], (DEPTH, A_WIDTH), 0.02),
        "w_spatial": nrm(ks[10], (DEPTH, A_GROUPS, CHUNK_MLP, CHUNK_MLP), CHUNK_MLP ** -0.5),
        "b_spatial": 1.0 + nrm(ks[11], (DEPTH, A_GROUPS, CHUNK_MLP), 0.02),
        "hgrn_lb": nrm(ks[12], (DEPTH + 1, 2, QK_WIDTH), 0.5),
        "hgrn_norm_g": 1.0 + nrm(ks[13], (DEPTH, H_B, DV), 0.02),
        "w_proj_a": nrm(ks[14], (DEPTH, A_WIDTH, D_MODEL), A_WIDTH ** -0.5),
        "w_proj_b": nrm(ks[15], (DEPTH, V_WIDTH, D_MODEL), V_WIDTH ** -0.5),
        "w_out": nrm(ks[16], (DEPTH, D_MODEL, D_MODEL), Dinv),
        "norm2_g": 1.0 + nrm(ks[17], (DEPTH, D_MODEL), 0.02),
        "peer_w_q": nrm(ks[18], (DEPTH, D_MODEL, PEER_HEADS * PEER_QDIM), Dinv),
        "peer_sub_keys": nrm(ks[19], (DEPTH, PEER_HEADS, 2, N_KEYS, PEER_QHALF), PEER_QHALF ** -0.5),
        "peer_u": nrm(ks[20], (DEPTH, N_EXPERTS, D_MODEL), Dinv),
        "peer_v": nrm(ks[21], (DEPTH, N_EXPERTS, D_MODEL), (PEER_HEADS * PEER_TOPK) ** -0.5),
        "final_norm_g": 1.0 + nrm(ks[22], (D_MODEL,), 0.02),
    }


def reference(x_prompt, x_sample, state_hgrn, c, c_ctx, w_ada, b_ada, norm1_g, w_in, sgu_norm_g,
              w_spatial, b_spatial, hgrn_lb, hgrn_norm_g, w_proj_a, w_proj_b, w_out, norm2_g,
              peer_w_q, peer_sub_keys, peer_u, peer_v, final_norm_g):
    lb = jnp.cumsum(jax.nn.softmax(hgrn_lb.astype(jnp.float32), axis=0), axis=0)[:DEPTH]
    xp = x_prompt
    xs = x_sample + grid_pos_embed(x_sample.shape[1]).astype(x_sample.dtype)[None]
    s_ctx0 = jnp.zeros((x_prompt.shape[0], 2, H_B, DK, DV), jnp.float32)
    ctx_states = []
    for l in range(DEPTH):
        params = (norm1_g[l], w_in[l], sgu_norm_g[l], w_spatial[l], b_spatial[l], hgrn_norm_g[l],
                  w_proj_a[l], w_proj_b[l], w_out[l], norm2_g[l], peer_w_q[l], peer_sub_keys[l],
                  peer_u[l], peer_v[l])
        mod_ctx = adaln(c_ctx[None].astype(xp.dtype), w_ada[l], b_ada[l])
        mod_lat = adaln(c, w_ada[l], b_ada[l])
        xp, s_ctx = trunk_layer(xp, mod_ctx, s_ctx0, lb[l], *params)
        xs, _ = trunk_layer(xs, mod_lat, state_hgrn[:, l].astype(jnp.float32), lb[l], *params)
        ctx_states.append(s_ctx)
    y_prompt = rmsnorm(xp, final_norm_g)
    y_sample = rmsnorm(xs, final_norm_g)
    new_state_hgrn = jnp.stack(ctx_states, axis=1)
    return (y_prompt, y_sample, new_state_hgrn)
```

```cpp
#include <hip/hip_runtime.h>
#include <hip/hip_cooperative_groups.h>
#include <cstdio>
namespace cg = cooperative_groups;

#ifndef N_LAUNCH_MODE
#define N_LAUNCH_MODE 0
#endif

#define LAS __attribute__((address_space(3)))
typedef unsigned short bf16_t;
typedef short bf16x8 __attribute__((ext_vector_type(8)));
typedef float f32x4 __attribute__((ext_vector_type(4)));
typedef unsigned u32x4 __attribute__((ext_vector_type(4)));
typedef unsigned u32x2 __attribute__((ext_vector_type(2)));

constexpr int NTOK = 8192, NPROMPT = 4096, DM = 1024, INW = 5632;
constexpr int NTHREADS = 512;
constexpr int LDS_BYTES = 150 * 1024;
constexpr float EPSN = 1e-6f;
constexpr float U_SCALE = 56.f, V_SCALE = 20.f;
constexpr size_t OUT_STATE_OFF = (size_t)NTOK * DM;

constexpr size_t MB = 1024 * 1024;
constexpr size_t WS_WINT = 0;
constexpr size_t WS_WAT = WS_WINT + (size_t)INW * DM * 2;
constexpr size_t WS_WBT = WS_WAT + 1 * MB;
constexpr size_t WS_WOUTT = WS_WBT + 1 * MB;
constexpr size_t WS_WQT = WS_WOUTT + 2 * MB;
constexpr size_t WS_KEYS = WS_WQT + 4 * MB;
constexpr size_t WS_WSP = WS_KEYS + 512 * 1024;
constexpr size_t WS_MOD = WS_WSP + 128 * 1024;
constexpr size_t WS_LB = WS_MOD + 128 * 1024;
constexpr size_t WS_AV = WS_LB + 64 * 1024;
constexpr size_t WS_X0S = WS_AV + 512 * 1024;
constexpr size_t WS_H = WS_X0S + 16 * MB;
constexpr size_t WS_YA = WS_H + 16 * MB;
constexpr size_t WS_YB = WS_YA + 8 * MB;
constexpr size_t WS_RA = WS_YB + 8 * MB;
constexpr size_t WS_U = WS_RA, WS_GV = WS_RA + 8 * MB, WS_Q = WS_RA + 16 * MB, WS_KF = WS_RA + 24 * MB, WS_LF = WS_RA + 32 * MB,
                 WS_KB = WS_RA + 40 * MB, WS_LFB = WS_RA + 48 * MB, WS_VI = WS_RA + 56 * MB, WS_SG = WS_RA + 64 * MB;
constexpr size_t WS_XP0 = WS_RA;
constexpr size_t WS_PM = WS_RA + 32 * MB;
constexpr size_t WS_QP = WS_RA;
constexpr size_t WS_IDX = WS_RA + 32 * MB;
constexpr size_t WS_GW = WS_RA + 36 * MB;
constexpr size_t WS_RC = WS_RA + 72 * MB;
constexpr size_t WS_SA = WS_RC, WS_SB = WS_RC + 16 * MB;
constexpr size_t WS_XP1 = WS_RC;
constexpr size_t WS_RB = WS_RC + 32 * MB;
constexpr size_t WS_UT = WS_RB;
constexpr size_t WS_X1 = WS_RB;
constexpr size_t WS_UTAB = WS_RB + 32 * MB;
constexpr size_t WS_VTAB = WS_RB + 48 * MB;
constexpr size_t WS_SINA = WS_H;
constexpr size_t WS_SINB = WS_RA;
constexpr size_t WS_BAR = WS_RB + 64 * MB;
constexpr size_t WS_END = WS_BAR + 64 * 1024;

struct Params {
    const float* in[23];
    float* out;
    unsigned char* ws;
    int ph_lo, ph_hi;
};

__device__ __forceinline__ unsigned cvt_pk_bf16(float lo, float hi) { unsigned r; asm volatile("v_cvt_pk_bf16_f32 %0, %1, %2" : "=v"(r) : "v"(lo), "v"(hi)); return r; }
__device__ __forceinline__ bf16_t f2bf(float f) { return (bf16_t)(cvt_pk_bf16(f, 0.f) & 0xffffu); }
__device__ __forceinline__ float bf2f(bf16_t b) { return __uint_as_float(((unsigned)b) << 16); }
__device__ __forceinline__ float bflo(unsigned u) { return __uint_as_float(u << 16); }
__device__ __forceinline__ float bfhi(unsigned u) { return __uint_as_float(u & 0xffff0000u); }
__device__ __forceinline__ float frcp(float x) { return __builtin_amdgcn_rcpf(x); }
__device__ __forceinline__ float sigm(float x) { return frcp(1.f + __expf(-x)); }
__device__ __forceinline__ float gelu_t(float x) { const float u = 0.7978845608028654f * (x + 0.044715f * x * x * x); return x * frcp(1.f + __expf(-2.f * u)); }
__device__ __forceinline__ float wave_sum(float v) {
#pragma unroll
    for (int o = 32; o > 0; o >>= 1) v += __shfl_xor(v, o, 64);
    return v;
}
__device__ __forceinline__ int otid() { int t = threadIdx.x; asm volatile("" : "+v"(t)); return t; }
__device__ __forceinline__ int mod_of_token(int tk) { return tk < NPROMPT ? 0 : 1 + ((tk - NPROMPT) >> 11); }


#define XB_TMO      128
#define XB_XCNT(j)  (256  + 64 * (j))
#define XB_XSUB(j)  (1280 + 64 * (j))
#define XB_XGEN(j)  (2304 + 64 * (j))
#define XB_TOP      3328
#define XB_TOPGEN   3392
#define XCD_BAR_WORDS 3456
#define XB_SPIN_CAP (1u << 18)
__device__ __forceinline__ unsigned xb_ld(unsigned* p)              { return __hip_atomic_load(p, __ATOMIC_RELAXED, __HIP_MEMORY_SCOPE_AGENT); }
__device__ __forceinline__ unsigned xb_add(unsigned* p, unsigned v) { return __hip_atomic_fetch_add(p, v, __ATOMIC_RELAXED, __HIP_MEMORY_SCOPE_AGENT); }
__device__ __forceinline__ unsigned xb_xcc_id() { return (unsigned)__builtin_amdgcn_s_getreg((3 << 11) | 20) & 0xFu; }
#define XB_SPIN(cond, bar) do { unsigned _sp = 0; while (cond) { __builtin_amdgcn_s_sleep(1); \
    if ((++_sp & 255u) == 0u) { if (xb_ld(&(bar)[XB_TMO])) break; if (_sp > XB_SPIN_CAP) { atomicAdd(&(bar)[XB_TMO], 1u); break; } } } } while (0)
struct XcdBarrier { unsigned* bar; unsigned x; volatile LAS unsigned* st; };
__device__ __forceinline__ XcdBarrier xcd_barrier_post(unsigned* bar, volatile LAS unsigned* st) {
    XcdBarrier b; b.bar = bar; b.x = xb_xcc_id(); b.st = st;
    if (threadIdx.x == 0) (void)xb_add(&bar[XB_XCNT(b.x)], 1u);
    return b;
}
__device__ __forceinline__ void xcd_barrier_complete(unsigned* bar, unsigned x, unsigned& nloc, unsigned& nx) {
    const unsigned G = gridDim.x * gridDim.y * gridDim.z;
    unsigned sum, cnt, mine, sp = 0u;
    for (;;) {
        sum = 0u; cnt = 0u; mine = 0u;
#pragma unroll
        for (unsigned j = 0; j < 16; ++j) { const unsigned c = xb_ld(&bar[XB_XCNT(j)]); sum += c; cnt += (c > 0u) ? 1u : 0u; mine = (j == x) ? c : mine; }
        if (sum == G) break;
        __builtin_amdgcn_s_sleep(1);
        if ((++sp & 255u) == 0u) { if (xb_ld(&bar[XB_TMO])) break; if (sp > XB_SPIN_CAP) { atomicAdd(&bar[XB_TMO], 1u); break; } }
    }
    nloc = mine > 0u ? mine : 1u; nx = cnt > 0u ? cnt : 1u;
}
__device__ __forceinline__ void xcd_barrier(const XcdBarrier& b) {
    asm volatile("s_waitcnt vmcnt(0)" ::: "memory");
    __syncthreads();
    if (threadIdx.x == 0) {
        unsigned* bar = b.bar;
        __builtin_amdgcn_s_waitcnt(0);
        unsigned nloc = b.st[0], nx = b.st[1];
        if (nloc == 0u) { xcd_barrier_complete(bar, b.x, nloc, nx); b.st[0] = nloc; b.st[1] = nx; }
        const unsigned old = xb_add(&bar[XB_XSUB(b.x)], 1u);
        const unsigned gen = old / nloc;
        if (old + 1u == (gen + 1u) * nloc) {
            __builtin_amdgcn_fence(__ATOMIC_RELEASE, "agent");
            asm volatile("s_waitcnt vmcnt(0)" ::: "memory");
            const unsigned og = xb_add(&bar[XB_TOP], 1u);
            const unsigned tg = og / nx;
            if (og + 1u == (tg + 1u) * nx) xb_add(&bar[XB_TOPGEN], 1u);
            else XB_SPIN(xb_ld(&bar[XB_TOPGEN]) == tg, bar);
            __builtin_amdgcn_fence(__ATOMIC_ACQUIRE, "agent");
            xb_add(&bar[XB_XGEN(b.x)], 1u);
            asm volatile("s_waitcnt vmcnt(0)" ::: "memory");
        } else {
            XB_SPIN(xb_ld(&bar[XB_XGEN(b.x)]) == gen, bar);
            __builtin_amdgcn_fence(__ATOMIC_ACQUIRE, "agent");
            asm volatile("s_waitcnt vmcnt(0)" ::: "memory");
        }
    }
    __syncthreads();
}

namespace pg8 {
constexpr int BM = 256, BK = 64, HALF = 128, HTB = HALF * BK * 2, STAGE_BYTES = 8 * HTB, NXCD = 8, WGM = 8;
__host__ __device__ __forceinline__ int lds_byte(int r, int c) { const int st = (r >> 4) * 2 + (c >> 5), rr = r & 15, cc = c & 31, ob = rr * 64 + cc * 2; return st * 1024 + (ob ^ (((ob >> 9) & 1) << 5)); }
__host__ __device__ __forceinline__ void stage_rc(int b, int& R, int& C) { const int st = b / 1024, sb = b % 1024, swz = sb ^ (((sb >> 9) & 1) << 5); R = (st >> 1) * 16 + swz / 64; C = (st & 1) * 32 + (swz % 64) / 2; }
__host__ __device__ __forceinline__ int perm32(int rho) { const int n = rho >> 4, i = rho & 15; return 8 * (i >> 2) + 4 * n + (i & 3); }
struct Unit { int pm, pn; };
struct Gemm { const bf16_t* A; const bf16_t* Bt; int M, N, K; int asplit; size_t astride; };
struct StaticOrder {
    int nM, nN, nwg, G, c;
    __host__ __device__ void init(int M, int N, int G_, int c_) { nM = M / BM; nN = N / BM; nwg = nM * nN; G = G_; c = c_; }
    __host__ __device__ bool next(int i, Unit& u) const {
        const long L = (long)i * G + c; if (L >= nwg) return false;
        int wgid = (int)L; { const int q = nwg / NXCD, r = nwg % NXCD, xcd = wgid % NXCD, off = wgid / NXCD; wgid = (xcd < r ? xcd * (q + 1) : r * (q + 1) + (xcd - r) * q) + off; }
        const int nig = WGM * nN, gid = wgid / nig, fm = gid * WGM, gsz = (nM - fm) < WGM ? (nM - fm) : WGM;
        u.pm = fm + ((wgid % nig) % gsz); u.pn = (wgid % nig) / gsz; return true;
    }
    __device__ __forceinline__ void a_ready(const Unit&) const {}
    __device__ __forceinline__ void done(const Unit&) const {}
};

template <class Epi, class Sched, bool MID>
__device__ __forceinline__ void gemm_phase(LAS unsigned char* lds, const Gemm g, const Sched& S, const Epi& E) {
    const int tid = otid(), wid = __builtin_amdgcn_readfirstlane(tid >> 6), lane = tid & 63, wr = wid >> 2, wc = wid & 3, fr = lane & 15, fq = lane >> 4;
    const int K = g.K, nt = K / BK;
    unsigned voffA[2], voffB[2];
#pragma unroll
    for (int i = 0; i < 2; ++i) { int R, C; stage_rc(tid * 16 + i * 8192, R, C); const int Rb = Epi::PERM ? ((R & ~31) + perm32(R & 31)) : R;
        voffA[i] = (unsigned)(R * K + C) * 2u; voffB[i] = (unsigned)(Rb * K + C) * 2u; }
    const size_t kstep = (size_t)(BK * 2);
    const size_t hstep = (size_t)HALF * K * 2;
    const size_t tstep = 2 * hstep;
    const unsigned ldsw = (unsigned)wid * 1024u;
    const int aoff = lds_byte(wr * 64 + fr, fq * 8), boff = lds_byte(wc * 32 + fr, fq * 8);
#define PG8_SA(b, h) (((b) * 2 + (h)) * HTB)
#define PG8_SB(b, h) ((4 + (b) * 2 + (h)) * HTB)
#define PG8_STAGE(bufoff, gbase, voff) do { _Pragma("unroll") for (int _i = 0; _i < 2; ++_i) \
        __builtin_amdgcn_global_load_lds((const unsigned*)((const char*)(gbase) + (voff)[_i]), (LAS unsigned*)(lds + (bufoff) + ldsw + _i * 8192), 16, 0, 0); } while (0)
#define PG8_LDA(dst, b, h) do { _Pragma("unroll") for (int m = 0; m < 4; ++m) _Pragma("unroll") for (int k = 0; k < 2; ++k) dst[m][k] = *(const LAS bf16x8*)(lds + PG8_SA(b, h) + aoff + m * 2048 + k * 1024); } while (0)
#define PG8_LDB(dst, b, h) do { _Pragma("unroll") for (int n = 0; n < 2; ++n) _Pragma("unroll") for (int k = 0; k < 2; ++k) dst[n][k] = *(const LAS bf16x8*)(lds + PG8_SB(b, h) + boff + n * 2048 + k * 1024); } while (0)
#define PG8_MMA(ai, bj, At, Bt) do { __builtin_amdgcn_s_setprio(1); _Pragma("unroll") for (int m = 0; m < 4; ++m) _Pragma("unroll") for (int n = 0; n < 2; ++n) _Pragma("unroll") for (int k = 0; k < 2; ++k) \
        acc[ai][bj][m][n] = __builtin_amdgcn_mfma_f32_16x16x32_bf16(Bt[n][k], At[m][k], acc[ai][bj][m][n], 0, 0, 0); __builtin_amdgcn_s_setprio(0); } while (0)
#define PG8_WAIT_V(n) asm volatile("s_waitcnt vmcnt(" #n ")" ::: "memory")
#define PG8_WAIT_L(n) asm volatile("s_waitcnt lgkmcnt(" #n ")" ::: "memory")
#define PG8_BAR __builtin_amdgcn_s_barrier()
#define PG8_SCHED __builtin_amdgcn_sched_barrier(0)
#define PG8_KBODY(t) do { \
            const bool last = (t == nt - 2); \
            const char* a1 = cA + (size_t)(t + 1) * kstep; \
            const char* a2 = last ? nA : cA + (size_t)(t + 2) * kstep; const char* b2 = last ? nB : cB + (size_t)(t + 2) * kstep; \
            const char* a3 = a2 + kstep; const char* b3 = b2 + kstep; \
            if (last && has_next) S.a_ready(nxt); \
            PG8_LDB(B0, 0, 0); PG8_SCHED; PG8_LDA(At, 0, 0); PG8_STAGE(PG8_SA(1, 1), a1 + hstep, voffA); \
            PG8_WAIT_L(8); PG8_BAR; PG8_WAIT_L(0); PG8_MMA(0, 0, At, B0); PG8_BAR; PG8_SCHED; \
            PG8_LDB(B1, 0, 1); PG8_STAGE(PG8_SB(0, 0), b2, voffB); \
            PG8_BAR; PG8_WAIT_L(0); PG8_MMA(0, 1, At, B1); PG8_BAR; \
            PG8_LDA(At, 0, 1); PG8_STAGE(PG8_SA(0, 0), a2, voffA); \
            PG8_BAR; PG8_WAIT_L(0); PG8_MMA(1, 0, At, B0); PG8_BAR; PG8_SCHED; \
            PG8_STAGE(PG8_SB(0, 1), b2 + hstep, voffB); \
            PG8_WAIT_V(6); PG8_BAR; PG8_MMA(1, 1, At, B1); PG8_BAR; \
            PG8_LDB(B0, 1, 0); PG8_SCHED; PG8_LDA(At, 1, 0); PG8_STAGE(PG8_SA(0, 1), a2 + hstep, voffA); \
            PG8_WAIT_L(8); PG8_BAR; PG8_WAIT_L(0); PG8_MMA(0, 0, At, B0); PG8_BAR; PG8_SCHED; \
            PG8_LDB(B1, 1, 1); PG8_STAGE(PG8_SB(1, 0), b3, voffB); \
            PG8_BAR; PG8_WAIT_L(0); PG8_MMA(0, 1, At, B1); PG8_BAR; \
            PG8_LDA(At, 1, 1); PG8_STAGE(PG8_SA(1, 0), a3, voffA); \
            PG8_BAR; PG8_WAIT_L(0); PG8_MMA(1, 0, At, B0); PG8_BAR; PG8_SCHED; \
            PG8_STAGE(PG8_SB(1, 1), b3 + hstep, voffB); \
            PG8_WAIT_V(6); PG8_BAR; PG8_MMA(1, 1, At, B1); PG8_BAR; \
        } while (0)
    Unit cur, nxt; int ui = 0;
    if (!S.next(0, cur)) return;
    f32x4 acc[2][2][4][2];
#pragma unroll
    for (int a = 0; a < 2; ++a)
#pragma unroll
        for (int b = 0; b < 2; ++b)
#pragma unroll
            for (int m = 0; m < 4; ++m)
#pragma unroll
                for (int n = 0; n < 2; ++n) acc[a][b][m][n] = (f32x4){0.f, 0.f, 0.f, 0.f};
    bf16x8 At[4][2], B0[2][2], B1[2][2];
    const char* cA = (const char*)g.A + (size_t)cur.pm * tstep + (g.asplit ? (size_t)(cur.pn / g.asplit) * g.astride : 0); const char* cB = (const char*)g.Bt + (size_t)cur.pn * tstep;
    S.a_ready(cur);
    PG8_STAGE(PG8_SB(0, 0), cB, voffB); PG8_STAGE(PG8_SA(0, 0), cA, voffA); PG8_STAGE(PG8_SB(0, 1), cB + hstep, voffB); PG8_STAGE(PG8_SA(0, 1), cA + hstep, voffA);
    if (wr == 1) PG8_BAR;
    PG8_WAIT_V(4); PG8_BAR;
    PG8_STAGE(PG8_SB(1, 0), cB + kstep, voffB); PG8_STAGE(PG8_SA(1, 0), cA + kstep, voffA); PG8_STAGE(PG8_SB(1, 1), cB + hstep + kstep, voffB);
    PG8_WAIT_V(6); PG8_BAR;
    for (;;) {
        const bool has_next = S.next(ui + 1, nxt);
        const char* nA = has_next ? (const char*)g.A + (size_t)nxt.pm * tstep + (g.asplit ? (size_t)(nxt.pn / g.asplit) * g.astride : 0) : cA; const char* nB = has_next ? (const char*)g.Bt + (size_t)nxt.pn * tstep : cB;
        if constexpr (MID) {
            for (int t = 0; t < (nt >> 1); t += 2) PG8_KBODY(t);
            { const int t2 = otid(), l2 = t2 & 63, w2 = __builtin_amdgcn_readfirstlane(t2 >> 6); E.mid(acc, cur, w2 >> 2, w2 & 3, l2 & 15, l2 >> 4); }
            for (int t = (nt >> 1); t < nt; t += 2) PG8_KBODY(t);
        } else {
            for (int t = 0; t < nt; t += 2) PG8_KBODY(t);
        }
        { const int t2 = otid(), l2 = t2 & 63, w2 = __builtin_amdgcn_readfirstlane(t2 >> 6); E(acc, cur, w2 >> 2, w2 & 3, l2 & 15, l2 >> 4); }
        if (!has_next) break;
#pragma unroll
        for (int a = 0; a < 2; ++a)
#pragma unroll
            for (int b = 0; b < 2; ++b)
#pragma unroll
                for (int m = 0; m < 4; ++m)
#pragma unroll
                    for (int n = 0; n < 2; ++n) acc[a][b][m][n] = (f32x4){0.f, 0.f, 0.f, 0.f};
        cur = nxt; cA = nA; cB = nB; ++ui;
    }
    PG8_WAIT_V(0);
    if (wr == 0) PG8_BAR;
    PG8_BAR;
#undef PG8_KBODY
#undef PG8_SA
#undef PG8_SB
#undef PG8_STAGE
#undef PG8_LDA
#undef PG8_LDB
#undef PG8_MMA
#undef PG8_WAIT_V
#undef PG8_WAIT_L
#undef PG8_BAR
#undef PG8_SCHED
}
}

__device__ __forceinline__ u32x4 pack8(f32x4 a, f32x4 b) { u32x4 w; w.x = cvt_pk_bf16(a[0], a[1]); w.y = cvt_pk_bf16(a[2], a[3]); w.z = cvt_pk_bf16(b[0], b[1]); w.w = cvt_pk_bf16(b[2], b[3]); return w; }

struct FZ {
    mutable size_t goff;
    unsigned char* ws;
    mutable int seg, cbase;
    __device__ __forceinline__ void begin(const pg8::Unit& u) const {
        const int pn = u.pn;
        if (pn < 14) { seg = pn >> 1; cbase = seg * 512; } else if (pn < 18) { seg = 7; cbase = 3584; } else { seg = 8; cbase = 4608; }
    }
    __device__ __forceinline__ void emit(int r, int c, f32x4 v0, f32x4 v1) const {
        const int cl = c - cbase;
        if (seg == 0 || seg == 1) {
#pragma unroll
            for (int j = 0; j < 4; ++j) { v0[j] = gelu_t(v0[j]); v1[j] = gelu_t(v1[j]); }
            bf16_t* o = (bf16_t*)(ws + (seg == 0 ? WS_U : WS_GV)) + (size_t)r * 512 + cl; *(u32x4*)o = pack8(v0, v1);
        } else if (seg == 2 || seg == 5) {
            bf16_t* o = (bf16_t*)(ws + (seg == 2 ? WS_Q : WS_VI)) + (size_t)r * 512 + cl; *(u32x4*)o = pack8(v0, v1);
        } else if (seg == 3 || seg == 4) {
            const int d = seg - 3;
            const float* lbp = (const float*)(ws + WS_LB) + d * 512 + cl;
            const f32x4 l0 = *(const f32x4*)lbp, l1 = *(const f32x4*)(lbp + 4);
            f32x4 k0, k1, g0, g1;
#pragma unroll
            for (int j = 0; j < 4; ++j) {
                { const float z = v0[j], e = __expf(-fabsf(z)), inv = frcp(1.f + e), sa = inv, sb = e * inv, sg = z >= 0.f ? sa : sb, nsg = z >= 0.f ? sb : sa, lb = l0[j];
                  k0[j] = (1.f - lb) * nsg; g0[j] = __logf(lb + (1.f - lb) * sg); }
                { const float z = v1[j], e = __expf(-fabsf(z)), inv = frcp(1.f + e), sa = inv, sb = e * inv, sg = z >= 0.f ? sa : sb, nsg = z >= 0.f ? sb : sa, lb = l1[j];
                  k1[j] = (1.f - lb) * nsg; g1[j] = __logf(lb + (1.f - lb) * sg); }
            }
            bf16_t* ok = (bf16_t*)(ws + (d == 0 ? WS_KF : WS_KB)) + (size_t)r * 512 + cl; *(u32x4*)ok = pack8(k0, k1);
            bf16_t* ol = (bf16_t*)(ws + (d == 0 ? WS_LF : WS_LFB)) + (size_t)r * 512 + cl; *(u32x4*)ol = pack8(g0, g1);
        } else if (seg == 6) {
#pragma unroll
            for (int j = 0; j < 4; ++j) { v0[j] = v0[j] * sigm(v0[j]); v1[j] = v1[j] * sigm(v1[j]); }
            bf16_t* o = (bf16_t*)(ws + WS_SG) + (size_t)r * 512 + cl; *(u32x4*)o = pack8(v0, v1);
        } else {
#pragma unroll
            for (int j = 0; j < 4; ++j) { v0[j] = sigm(v0[j]); v1[j] = sigm(v1[j]); }
            bf16_t* o = (bf16_t*)(ws + (seg == 7 ? WS_SA : WS_SB)) + goff; *(u32x4*)o = pack8(v0, v1);
        }
    }
};
struct FAB {
    mutable size_t goff;
    unsigned char* ws;
    __device__ __forceinline__ void begin(const pg8::Unit&) const {}
    __device__ __forceinline__ void emit(int r, int c, f32x4 v0, f32x4 v1) const {
        const u32x4 s = *(const u32x4*)((const bf16_t*)(ws + WS_SB) + goff);
        f32x4 a, b;
        a[0] = v0[0] * bflo(s.x); a[1] = v0[1] * bfhi(s.x); a[2] = v0[2] * bflo(s.y); a[3] = v0[3] * bfhi(s.y);
        b[0] = v1[0] * bflo(s.z); b[1] = v1[1] * bfhi(s.z); b[2] = v1[2] * bflo(s.w); b[3] = v1[3] * bfhi(s.w);
        *(u32x4*)((bf16_t*)(ws + WS_PM) + (size_t)(c >> 9) * NTOK * 512 + (size_t)r * 512 + (c & 511)) = pack8(a, b);
    }
    __device__ __forceinline__ void scale(int r, int c, f32x4& v0, f32x4& v1) const {
        const u32x4 sa = *(const u32x4*)((const bf16_t*)(ws + WS_SA) + goff);
        const u32x4 sb = *(const u32x4*)((const bf16_t*)(ws + WS_SB) + goff);
        v0[0] *= bflo(sa.x) * frcp(bflo(sb.x)); v0[1] *= bfhi(sa.x) * frcp(bfhi(sb.x)); v0[2] *= bflo(sa.y) * frcp(bflo(sb.y)); v0[3] *= bfhi(sa.y) * frcp(bfhi(sb.y));
        v1[0] *= bflo(sa.z) * frcp(bflo(sb.z)); v1[1] *= bfhi(sa.z) * frcp(bfhi(sb.z)); v1[2] *= bflo(sa.w) * frcp(bflo(sb.w)); v1[3] *= bfhi(sa.w) * frcp(bfhi(sb.w));
    }
};
struct FOUT {
    mutable size_t goff;
    unsigned char* ws; const float* xp;
    __device__ __forceinline__ void begin(const pg8::Unit&) const {}
    __device__ __forceinline__ void emit(int r, int c, f32x4 v0, f32x4 v1) const {
        float* o = (float*)(ws + ((c >> 10) ? WS_XP1 : WS_XP0)) + (size_t)r * 1024 + (c & 1023);
        *(f32x4*)o = v0; *(f32x4*)(o + 4) = v1;
    }
};
struct FQ {
    mutable size_t goff;
    unsigned char* ws;
    __device__ __forceinline__ void begin(const pg8::Unit&) const {}
    __device__ __forceinline__ void emit(int r, int c, f32x4 v0, f32x4 v1) const {
        *(u32x4*)((bf16_t*)(ws + WS_QP) + (size_t)r * 2048 + c) = pack8(v0, v1);
    }
};

struct EpiAll {
    static constexpr bool PERM = true;
    unsigned char* ws; const float* xp; int mode;
    template <class F> __device__ __forceinline__ void run(const F& f, const f32x4 (&acc)[2][2][4][2], const pg8::Unit& u, int wr, int wc, int fr, int fq) const {
        const int pnadd = (mode == 0) ? 2 : 0;
        f.begin(u);
#pragma unroll
        for (int ai = 0; ai < 2; ++ai)
#pragma unroll
            for (int m = 0; m < 4; ++m)
#pragma unroll
                for (int bj = 0; bj < 2; ++bj) {
                    const int r = u.pm * 256 + ai * 128 + wr * 64 + m * 16 + fr, c = u.pn * 256 + bj * 128 + wc * 32 + 8 * fq;
                    f.goff = ((size_t)((u.pm * 4 + ((u.pn + pnadd) & 3)) * 16 + (ai * 8 + m * 2 + bj))) * 4096 + (size_t)((wr * 4 + wc) * 64 + fq * 16 + fr) * 8;
                    f.emit(r, c, acc[ai][bj][m][0], acc[ai][bj][m][1]);
                }
    }
    __device__ __forceinline__ void mid(f32x4 (&acc)[2][2][4][2], const pg8::Unit& u, int wr, int wc, int fr, int fq) const {
        if (mode != 1) return;
        FAB f; f.ws = ws;
#pragma unroll
        for (int ai = 0; ai < 2; ++ai)
#pragma unroll
            for (int m = 0; m < 4; ++m)
#pragma unroll
                for (int bj = 0; bj < 2; ++bj) {
                    const int r = u.pm * 256 + ai * 128 + wr * 64 + m * 16 + fr, c = u.pn * 256 + bj * 128 + wc * 32 + 8 * fq;
                    f.goff = ((size_t)((u.pm * 4 + (u.pn & 3)) * 16 + (ai * 8 + m * 2 + bj))) * 4096 + (size_t)((wr * 4 + wc) * 64 + fq * 16 + fr) * 8;
                    f.scale(r, c, acc[ai][bj][m][0], acc[ai][bj][m][1]);
                    __builtin_amdgcn_sched_barrier(0);
                }
    }
    __device__ __forceinline__ void operator()(const f32x4 (&acc)[2][2][4][2], const pg8::Unit& u, int wr, int wc, int fr, int fq) const {
        if (mode == 0) { FZ f; f.ws = ws; f.seg = 0; f.cbase = 0; run(f, acc, u, wr, wc, fr, fq); }
        else if (mode == 1) { FAB f; f.ws = ws; run(f, acc, u, wr, wc, fr, fq); }
        else if (mode == 3) { FOUT f; f.ws = ws; f.xp = xp; run(f, acc, u, wr, wc, fr, fq); }
        else { FQ f; f.ws = ws; run(f, acc, u, wr, wc, fr, fq); }
    }
};
__device__ __forceinline__ void run_gemm(LAS unsigned char* lds, const bf16_t* A, const bf16_t* Bt, int M, int N, int K, int asplit, size_t astride, const EpiAll& E) {
    pg8::Gemm g; g.A = A; g.Bt = Bt; g.M = M; g.N = N; g.K = K; g.asplit = asplit; g.astride = astride;
    pg8::StaticOrder S; S.init(M, N, (int)gridDim.x, (int)blockIdx.x);
    if (E.mode == 1) pg8::gemm_phase<EpiAll, pg8::StaticOrder, true>(lds, g, S, E); else pg8::gemm_phase<EpiAll, pg8::StaticOrder, false>(lds, g, S, E);
}

struct TrJob { const float* src; bf16_t* dst; int K, N, k0, n0, kd; };
__device__ __forceinline__ bool tr_job(const Params& p, int t, TrJob& j) {
    int ntn; j.kd = 0;
    if (t < 704) { j.src = p.in[8]; j.dst = (bf16_t*)(p.ws + WS_WINT); j.K = 1024; j.N = INW; ntn = 44; }
    else if (t < 768) { t -= 704; j.src = p.in[14]; j.dst = (bf16_t*)(p.ws + WS_WAT); j.K = 1024; j.N = 1024; ntn = 8; }
    else if (t < 832) { t -= 768; j.src = p.in[15]; j.dst = (bf16_t*)(p.ws + WS_WAT); j.K = 1024; j.N = 1024; ntn = 8; j.kd = 512; }
    else if (t < 960) { t -= 832; j.src = p.in[16]; j.dst = (bf16_t*)(p.ws + WS_WOUTT); j.K = 512; j.N = 1024; ntn = 8;
        if (t / ntn >= 8) { j.dst += 1024 * 512; j.kd = -512; } }
    else if (t < 1216) { t -= 960; j.src = p.in[18]; j.dst = (bf16_t*)(p.ws + WS_WQT); j.K = 1024; j.N = 2048; ntn = 16; }
    else return false;
    const int tk = t / ntn, tn = t - tk * ntn; j.k0 = tk * 64; j.n0 = tn * 128; return true;
}
__device__ __forceinline__ void tr_load(const TrJob& j, int tid, f32x4 (&r)[4]) {
#pragma unroll
    for (int i = 0; i < 4; ++i) { const int k = (tid >> 5) + 16 * i, c = (tid & 31) * 4; r[i] = __builtin_nontemporal_load((const f32x4*)(j.src + (size_t)(j.k0 + k) * j.N + j.n0 + c)); }
}
__device__ __forceinline__ void transpose_all(const Params& p, LAS float* tl, int t_lo, int t_hi, int w, int nw) {
    const int tid = otid();
    TrJob cur, nxt; f32x4 r[4];
    int t = t_lo + w; bool have = t < t_hi && tr_job(p, t, cur);
    if (have) tr_load(cur, tid, r);
    while (have) {
#pragma unroll
        for (int i = 0; i < 4; ++i) { const int k = (tid >> 5) + 16 * i, c = (tid & 31) * 4; LAS float* o = tl + k * 129 + c; o[0] = r[i][0]; o[1] = r[i][1]; o[2] = r[i][2]; o[3] = r[i][3]; }
        __syncthreads();
        t += nw; const bool hn = t < t_hi && tr_job(p, t, nxt);
        if (hn) tr_load(nxt, tid, r);
#pragma unroll
        for (int i = 0; i < 2; ++i) { const int idx = tid + 512 * i, n = idx >> 3, ks = idx & 7;
            float f[8];
#pragma unroll
            for (int q = 0; q < 8; ++q) f[q] = tl[(ks * 8 + q) * 129 + n];
            u32x4 w; w.x = cvt_pk_bf16(f[0], f[1]); w.y = cvt_pk_bf16(f[2], f[3]); w.z = cvt_pk_bf16(f[4], f[5]); w.w = cvt_pk_bf16(f[6], f[7]);
            *(u32x4*)(cur.dst + (size_t)(cur.n0 + n) * cur.K + cur.kd + cur.k0 + ks * 8) = w; }
        __syncthreads();
        cur = nxt; have = hn;
    }
}
__device__ __forceinline__ void convert_item(const float* __restrict__ src, bf16_t* __restrict__ dst, int item) {
    const size_t base = (size_t)item * 8192 + otid();
#pragma unroll 4
    for (int i = 0; i < 16; ++i) {
        const size_t q = base + (size_t)i * 512;
        const f32x4 v = *(const f32x4*)(src + q * 4);
        u32x2 w; w.x = cvt_pk_bf16(v[0], v[1]); w.y = cvt_pk_bf16(v[2], v[3]);
        *(u32x2*)(dst + q * 4) = w;
    }
}
__device__ __forceinline__ void convert_item_fp4(const float* __restrict__ src, unsigned* __restrict__ dst, int item, float scale) {
    const size_t base = (size_t)item * 4096 + otid();
#pragma unroll 1
    for (int hf = 0; hf < 2; ++hf) {
        f32x4 v[8];
#pragma unroll
        for (int i = 0; i < 4; ++i) { const float* sp = src + (base + (size_t)(hf * 4 + i) * 512) * 8;
            v[2 * i] = __builtin_nontemporal_load((const f32x4*)sp); v[2 * i + 1] = __builtin_nontemporal_load((const f32x4*)(sp + 4)); }
#pragma unroll
        for (int i = 0; i < 4; ++i) {
            f32x4 a = v[2 * i], b = v[2 * i + 1];
#pragma unroll
            for (int j = 0; j < 4; ++j) { a[j] = fminf(fmaxf(a[j] * scale, -6.f), 6.f); b[j] = fminf(fmaxf(b[j] * scale, -6.f), 6.f); }
            unsigned w = 0;
            w = __builtin_amdgcn_cvt_scalef32_pk_fp4_f32(w, a[0], a[1], 1.0f, 0);
            w = __builtin_amdgcn_cvt_scalef32_pk_fp4_f32(w, a[2], a[3], 1.0f, 1);
            w = __builtin_amdgcn_cvt_scalef32_pk_fp4_f32(w, b[0], b[1], 1.0f, 2);
            w = __builtin_amdgcn_cvt_scalef32_pk_fp4_f32(w, b[2], b[3], 1.0f, 3);
            dst[base + (size_t)(hf * 4 + i) * 512] = w;
        }
    }
}
__device__ void phase_prep(const Params& p, LAS unsigned char* lds) {
    const int tid = otid();
    LAS float* sl = (LAS float*)lds;
    LAS float* red = (LAS float*)(lds + 12288);
    LAS float* tl = (LAS float*)(lds + 20480);
    for (int i = tid; i < 3072; i += NTHREADS) {
        const int m = i >> 10, k = i & 1023;
        const float cv = (m == 0) ? p.in[4][k] : p.in[3][(m - 1) * 1024 + k];
        sl[i] = cv * sigm(cv);
    }
    __syncthreads();
    transpose_all(p, tl, 0, gridDim.x == 256 ? 704 : 1216, blockIdx.x, gridDim.x);
    constexpr int I4 = 0;
    constexpr int I5 = I4 + 192;
    constexpr int I6 = I5 + 8;
    constexpr int I7 = I6 + 2;
    constexpr int I8 = I7 + 1;
    for (int it = (blockIdx.x + 64) % gridDim.x; it < I8; it += gridDim.x) {
        if (false) {}
        else if (it < I5) {
            const int c0 = (it - I4) * 32, col = tid & 31, ks = tid >> 5;
            const float* w = p.in[5] + c0 + col;
            float a0 = 0.f, a1 = 0.f, a2 = 0.f;
#pragma unroll 16
            for (int i = 0; i < 64; ++i) { const int k = ks + 16 * i; const float wv = __builtin_nontemporal_load(w + (size_t)k * 6144); a0 += sl[k] * wv; a1 += sl[1024 + k] * wv; a2 += sl[2048 + k] * wv; }
            red[(ks * 3 + 0) * 32 + col] = a0; red[(ks * 3 + 1) * 32 + col] = a1; red[(ks * 3 + 2) * 32 + col] = a2;
            __syncthreads();
            if (tid < 96) {
                const int m = tid >> 5, cc = tid & 31; float s = p.in[6][c0 + cc];
#pragma unroll
                for (int q = 0; q < 16; ++q) s += red[(q * 3 + m) * 32 + cc];
                ((float*)(p.ws + WS_MOD))[m * 6144 + c0 + cc] = s;
            }
            __syncthreads();
        }
        else if (it < I6) convert_item(p.in[19], (bf16_t*)(p.ws + WS_KEYS), it - I5);
        else if (it < I7) convert_item(p.in[10], (bf16_t*)(p.ws + WS_WSP), it - I6);
        else {
            for (int i = tid; i < 1024; i += NTHREADS) ((float*)(p.ws + WS_LB))[i] = sigm(p.in[12][i] - p.in[12][1024 + i]);
        }
    }
}

__device__ __forceinline__ f32x4 pos_embed4(int pos, int lane, int i) {
    const float base = (i < 2) ? (float)(pos >> 6) : (float)(pos & 63);
    f32x4 r;
#pragma unroll
    for (int j = 0; j < 4; ++j) {
        const int d = lane * 4 + j;
        const float om = exp2f((float)d * (-13.287712379549449f / 256.0f));
        const float ang = base * om;
        r[j] = (i & 1) ? __cosf(ang) : __sinf(ang);
    }
    return r;
}
__device__ void phase_norm1(const Params& p) {
    const int tid_ = otid(), lane = tid_ & 63, wid = tid_ >> 6;
    const float* g1 = p.in[7];
    const int stride = gridDim.x * 8;
    for (int tkb = blockIdx.x * 8 + wid; tkb < NTOK; tkb += 4 * stride) {
        f32x4 xs[4][4];
#pragma unroll
        for (int q = 0; q < 4; ++q) { const int tk = tkb + q * stride;
            if (tk < NTOK) { const float* xr = tk < NPROMPT ? p.in[0] + (size_t)tk * 1024 : p.in[1] + (size_t)(tk - NPROMPT) * 1024;
#pragma unroll
                for (int i = 0; i < 4; ++i) xs[q][i] = __builtin_nontemporal_load((const f32x4*)(xr + lane * 4 + 256 * i)); } }
#pragma unroll
        for (int q = 0; q < 4; ++q) {
            const int tk = tkb + q * stride;
            if (tk >= NTOK) break;
            const float* mod = (const float*)(p.ws + WS_MOD) + mod_of_token(tk) * 6144;
            f32x4 x[4]; float ss = 0.f;
#pragma unroll
            for (int i = 0; i < 4; ++i) x[i] = xs[q][i];
            if (tk >= NPROMPT) {
                const int pos = (tk - NPROMPT) & 2047;
#pragma unroll
                for (int i = 0; i < 4; ++i) x[i] += pos_embed4(pos, lane, i);
            }
#pragma unroll
            for (int i = 0; i < 4; ++i) ss += x[i][0] * x[i][0] + x[i][1] * x[i][1] + x[i][2] * x[i][2] + x[i][3] * x[i][3];
            ss = wave_sum(ss);
            const float rstd = rsqrtf(ss * (1.f / 1024.f) + EPSN);
            bf16_t* ho = (bf16_t*)(p.ws + WS_H) + (size_t)tk * 1024;
#pragma unroll
            for (int i = 0; i < 4; ++i) {
                const int c = lane * 4 + 256 * i;
                const f32x4 g = *(const f32x4*)(g1 + c), sh = *(const f32x4*)(mod + c), sc = *(const f32x4*)(mod + 1024 + c);
                f32x4 h;
#pragma unroll
                for (int j = 0; j < 4; ++j) h[j] = x[i][j] * rstd * g[j] * (1.f + sc[j]) + sh[j];
                u32x2 w; w.x = cvt_pk_bf16(h[0], h[1]); w.y = cvt_pk_bf16(h[2], h[3]);
                *(u32x2*)(ho + c) = w;
            }
        }
    }
}
__device__ __forceinline__ void convert_tables(const Params& p, int lo, int hi, int w, int nw) {
    for (int it = lo + w; it < hi; it += nw) {
        if (it < 512) convert_item_fp4(p.in[20], (unsigned*)(p.ws + WS_UTAB), it, U_SCALE);
        else convert_item_fp4(p.in[21], (unsigned*)(p.ws + WS_VTAB), it - 512, V_SCALE);
    }
}
__device__ void phase_norm2(const Params& p) {
    const int tid_ = otid(), lane = tid_ & 63, wid = tid_ >> 6;
    const float* g2 = p.in[17];
    if (gridDim.x <= 128) convert_tables(p, 0, 1024, blockIdx.x, gridDim.x);
    const int stride = gridDim.x * 8;
    for (int tkb = blockIdx.x * 8 + wid; tkb < NTOK; tkb += 4 * stride) {
        f32x4 xs[4][4];
#pragma unroll
        for (int q = 0; q < 4; ++q) { const int tk = tkb + q * stride;
            if (tk < NTOK) { const float* p0 = (const float*)(p.ws + WS_XP0) + (size_t)tk * 1024; const float* p1 = (const float*)(p.ws + WS_XP1) + (size_t)tk * 1024;
                const float* xr = tk < NPROMPT ? p.in[0] + (size_t)tk * 1024 : p.in[1] + (size_t)(tk - NPROMPT) * 1024;
                const float* gp = (const float*)(p.ws + WS_MOD) + mod_of_token(tk) * 6144 + 2 * 1024;
                float* xo = (float*)(p.ws + WS_X1) + (size_t)tk * 1024;
#pragma unroll
                for (int i = 0; i < 4; ++i) { const int c = lane * 4 + 256 * i;
                    xs[q][i] = *(const f32x4*)(xr + c) + *(const f32x4*)(gp + c) * (*(const f32x4*)(p0 + c) + *(const f32x4*)(p1 + c));
                    if (tk >= NPROMPT) xs[q][i] += pos_embed4((tk - NPROMPT) & 2047, lane, i);
                    *(f32x4*)(xo + c) = xs[q][i]; } } }
#pragma unroll
        for (int q = 0; q < 4; ++q) {
            const int tk = tkb + q * stride;
            if (tk >= NTOK) break;
            const float* mod = (const float*)(p.ws + WS_MOD) + mod_of_token(tk) * 6144;
            float ss = 0.f;
#pragma unroll
            for (int i = 0; i < 4; ++i) ss += xs[q][i][0] * xs[q][i][0] + xs[q][i][1] * xs[q][i][1] + xs[q][i][2] * xs[q][i][2] + xs[q][i][3] * xs[q][i][3];
            ss = wave_sum(ss);
            const float rstd = rsqrtf(ss * (1.f / 1024.f) + EPSN);
            bf16_t* ho = (bf16_t*)(p.ws + WS_H) + (size_t)tk * 1024;
#pragma unroll
            for (int i = 0; i < 4; ++i) {
                const int c = lane * 4 + 256 * i;
                const f32x4 g = *(const f32x4*)(g2 + c), sh = *(const f32x4*)(mod + 3 * 1024 + c), sc = *(const f32x4*)(mod + 4 * 1024 + c);
                f32x4 h;
#pragma unroll
                for (int j = 0; j < 4; ++j) h[j] = xs[q][i][j] * rstd * g[j] * (1.f + sc[j]) + sh[j];
                u32x2 w; w.x = cvt_pk_bf16(h[0], h[1]); w.y = cvt_pk_bf16(h[2], h[3]);
                *(u32x2*)(ho + c) = w;
            }
        }
    }
}

#define MFMA16(a, b, c) __builtin_amdgcn_mfma_f32_16x16x32_bf16((a), (b), (c), 0, 0, 0)
__device__ void gmlp_item(const Params& p, LAS unsigned char* lds, int item) {
    const int tid = otid(), lane = tid & 63, wid = tid >> 6, fr = lane & 15, fq = lane >> 4;
    const int ck = item >> 2, g = item & 3, t0 = ck * 128;
    LAS bf16_t* AS = (LAS bf16_t*)lds;
    LAS bf16_t* VT = (LAS bf16_t*)(lds + 34816);
    LAS float* rs = (LAS float*)(lds + 69632);
    const bf16_t* GV = (const bf16_t*)(p.ws + WS_GV);
    {
        const int s = tid >> 2, part = tid & 3;
        const u32x4* rp = (const u32x4*)(GV + (size_t)(t0 + s) * 512 + part * 128);
        float ss = 0.f;
#pragma unroll
        for (int i = 0; i < 16; ++i) { const u32x4 w = rp[i];
            const float a0 = bflo(w.x), a1 = bfhi(w.x), a2 = bflo(w.y), a3 = bfhi(w.y), a4 = bflo(w.z), a5 = bfhi(w.z), a6 = bflo(w.w), a7 = bfhi(w.w);
            ss += a0 * a0 + a1 * a1 + a2 * a2 + a3 * a3 + a4 * a4 + a5 * a5 + a6 * a6 + a7 * a7; }
        ss += __shfl_xor(ss, 1, 64); ss += __shfl_xor(ss, 2, 64);
        if (part == 0) rs[s] = rsqrtf(ss * (1.f / 512.f) + EPSN);
    }
    {
        const bf16_t* W = (const bf16_t*)(p.ws + WS_WSP) + g * 16384;
#pragma unroll
        for (int i = 0; i < 4; ++i) { const int idx = tid + 512 * i, row = idx >> 4, sg = idx & 15;
            *(LAS u32x4*)(AS + row * 136 + sg * 8) = *(const u32x4*)(W + row * 128 + sg * 8); }
    }
    __syncthreads();
    {
        const float* ng = p.in[9] + g * 128;
#pragma unroll
        for (int i = 0; i < 4; ++i) { const int idx = tid + 512 * i, s = idx >> 4, c8 = idx & 15;
            const u32x4 w = *(const u32x4*)(GV + (size_t)(t0 + s) * 512 + g * 128 + c8 * 8);
            const float r = rs[s]; const f32x4 n0 = *(const f32x4*)(ng + c8 * 8), n1 = *(const f32x4*)(ng + c8 * 8 + 4);
            LAS bf16_t* o = VT + (c8 * 8) * 136 + s;
            o[0 * 136] = f2bf(bflo(w.x) * r * n0[0]); o[1 * 136] = f2bf(bfhi(w.x) * r * n0[1]);
            o[2 * 136] = f2bf(bflo(w.y) * r * n0[2]); o[3 * 136] = f2bf(bfhi(w.y) * r * n0[3]);
            o[4 * 136] = f2bf(bflo(w.z) * r * n1[0]); o[5 * 136] = f2bf(bfhi(w.z) * r * n1[1]);
            o[6 * 136] = f2bf(bflo(w.w) * r * n1[2]); o[7 * 136] = f2bf(bfhi(w.w) * r * n1[3]); }
    }
    __syncthreads();
    {
        bf16x8 bt[4];
#pragma unroll
        for (int ks = 0; ks < 4; ++ks) bt[ks] = *(const LAS bf16x8*)(AS + (16 * wid + fr) * 136 + ks * 32 + fq * 8);
        const int tl = 16 * wid + fr, tok = t0 + tl;
        const float bs = p.in[11][g * 128 + tl];
        const bf16_t* U = (const bf16_t*)(p.ws + WS_U) + (size_t)tok * 512 + g * 128;
        bf16_t* YA = (bf16_t*)(p.ws + WS_YA) + (size_t)tok * 1024 + g * 128;
#pragma unroll
        for (int ct = 0; ct < 8; ++ct) {
            f32x4 acc = {0.f, 0.f, 0.f, 0.f};
#pragma unroll
            for (int ks = 0; ks < 4; ++ks) { const bf16x8 a = *(const LAS bf16x8*)(VT + (16 * ct + fr) * 136 + ks * 32 + fq * 8); acc = MFMA16(a, bt[ks], acc); }
            const int c = 16 * ct + 4 * fq;
            const u32x2 uu = *(const u32x2*)(U + c);
            u32x2 w; w.x = cvt_pk_bf16(bflo(uu.x) * (acc[0] + bs), bfhi(uu.x) * (acc[1] + bs)); w.y = cvt_pk_bf16(bflo(uu.y) * (acc[2] + bs), bfhi(uu.y) * (acc[3] + bs));
            *(u32x2*)(YA + c) = w;
        }
    }
    __syncthreads();
}
struct S1Regs { u32x4 rk[2][2], rl[2][2], rv[2]; };
__device__ __forceinline__ void s1_load(const Params& p, int item, int tid, S1Regs& R) {
    const int gc = item >> 2, h = item & 3, t0 = gc * 64;
#pragma unroll
    for (int i = 0; i < 2; ++i) { const int idx = tid + 512 * i, s = idx >> 4, c8 = idx & 15; const size_t go = (size_t)(t0 + s) * 512 + h * 128 + c8 * 8;
        R.rk[0][i] = *(const u32x4*)((const bf16_t*)(p.ws + WS_KF) + go); R.rl[0][i] = *(const u32x4*)((const bf16_t*)(p.ws + WS_LF) + go);
        R.rk[1][i] = *(const u32x4*)((const bf16_t*)(p.ws + WS_KB) + go); R.rl[1][i] = *(const u32x4*)((const bf16_t*)(p.ws + WS_LFB) + go);
        R.rv[i] = *(const u32x4*)((const bf16_t*)(p.ws + WS_VI) + go); }
}
__device__ __forceinline__ void scan1_item(const Params& p, LAS unsigned char* lds, int item, int next_item, S1Regs& R) {
    const int tid = otid(), lane = tid & 63, wid = tid >> 6, fr = lane & 15, fq = lane >> 4;
    const int gc = item >> 2, h = item & 3, t0 = gc * 64;
    LAS bf16_t* VT = (LAS bf16_t*)lds;
    LAS bf16_t* KDT = (LAS bf16_t*)(lds + 18432);
    LAS bf16_t* KS = (LAS bf16_t*)(lds + 55296);
    LAS bf16_t* LS = (LAS bf16_t*)(lds + 90112);
    {
#pragma unroll
        for (int i = 0; i < 2; ++i) { const int idx = tid + 512 * i, s = idx >> 4, c8 = idx & 15;
#pragma unroll
            for (int d = 0; d < 2; ++d) { *(LAS u32x4*)(KS + (d * 64 + s) * 136 + c8 * 8) = R.rk[d][i]; *(LAS u32x4*)(LS + (d * 64 + s) * 136 + c8 * 8) = R.rl[d][i]; }
            const u32x4 w = R.rv[i]; LAS bf16_t* o = VT + (c8 * 8) * 72 + s;
            o[0 * 72] = (bf16_t)(w.x & 0xffff); o[1 * 72] = (bf16_t)(w.x >> 16); o[2 * 72] = (bf16_t)(w.y & 0xffff); o[3 * 72] = (bf16_t)(w.y >> 16);
            o[4 * 72] = (bf16_t)(w.z & 0xffff); o[5 * 72] = (bf16_t)(w.z >> 16); o[6 * 72] = (bf16_t)(w.w & 0xffff); o[7 * 72] = (bf16_t)(w.w >> 16); }
        if (next_item >= 0) s1_load(p, next_item, tid, R);
    }
    __syncthreads();
    if (tid < 256) {
        const int d = tid >> 7, k = tid & 127;
        LAS bf16_t* o = KDT + (d * 128 + k) * 72;
        float run = 0.f;
#pragma unroll 8
        for (int j = 63; j >= 0; --j) {
            const int loc = d == 0 ? j : 63 - j;
            const float kv = bf2f(KS[(d * 64 + loc) * 136 + k]), lf = bf2f(LS[(d * 64 + loc) * 136 + k]);
            o[loc] = f2bf(kv * __expf(run));
            run += lf;
        }
        ((float*)(p.ws + WS_AV))[(size_t)(item * 2 + d) * 128 + k] = __expf(run);
    }
    __syncthreads();
    {
        bf16x8 bv[2];
#pragma unroll
        for (int ks = 0; ks < 2; ++ks) bv[ks] = *(const LAS bf16x8*)(VT + (16 * wid + fr) * 72 + ks * 32 + fq * 8);
#pragma unroll
        for (int d = 0; d < 2; ++d) {
            float* UT = (float*)(p.ws + WS_UT) + (size_t)(item * 2 + d) * 16384 + (16 * wid + fr) * 128;
#pragma unroll
            for (int kt = 0; kt < 8; ++kt) {
                f32x4 acc = {0.f, 0.f, 0.f, 0.f};
#pragma unroll
                for (int ks = 0; ks < 2; ++ks) { const bf16x8 a = *(const LAS bf16x8*)(KDT + (d * 128 + 16 * kt + fr) * 72 + ks * 32 + fq * 8); acc = MFMA16(a, bv[ks], acc); }
                *(f32x4*)(UT + 16 * kt + 4 * fq) = acc;
            }
        }
    }
    __syncthreads();
}
__device__ void phase_mix1(const Params& p, LAS unsigned char* lds) {
    if (gridDim.x == 256) {
        S1Regs R; s1_load(p, blockIdx.x, otid(), R);
        gmlp_item(p, lds, blockIdx.x);
        scan1_item(p, lds, blockIdx.x, blockIdx.x + 256, R); scan1_item(p, lds, blockIdx.x + 256, -1, R);
    } else {
        for (int it = blockIdx.x; it < 256; it += gridDim.x) gmlp_item(p, lds, it);
        for (int it = blockIdx.x; it < 512; it += gridDim.x) { S1Regs R; s1_load(p, it, otid(), R); scan1_item(p, lds, it, -1, R); }
    }
}

__device__ __forceinline__ bf16_t* sin_ptr(unsigned char* ws, size_t si) { return si < 512 ? (bf16_t*)(ws + WS_SINA) + si * 16384 : (bf16_t*)(ws + WS_SINB) + (si - 512) * 16384; }
template <int NB>
__device__ __forceinline__ void scan2_run(const Params& p, int gcb, int n, int h, int d, int v, int k0, f32x4& S) {
    const float* __restrict__ UT = (const float*)(p.ws + WS_UT);
    const float* __restrict__ AV = (const float*)(p.ws + WS_AV);
    for (int i0 = 0; i0 < n; i0 += NB) {
        f32x4 ub[NB], ab[NB];
#pragma unroll
        for (int j = 0; j < NB; ++j) { const int ci = d ? n - 1 - (i0 + j) : (i0 + j); const size_t si = (size_t)((gcb + ci) * 4 + h) * 2 + d;
            ub[j] = *(const f32x4*)(UT + si * 16384 + v * 128 + k0); ab[j] = *(const f32x4*)(AV + si * 128 + k0); }
#pragma unroll
        for (int j = 0; j < NB; ++j) { const int ci = d ? n - 1 - (i0 + j) : (i0 + j); const size_t si = (size_t)((gcb + ci) * 4 + h) * 2 + d;
            u32x2 w; w.x = cvt_pk_bf16(S[0], S[1]); w.y = cvt_pk_bf16(S[2], S[3]);
            *(u32x2*)(sin_ptr(p.ws, si) + v * 128 + k0) = w;
            S = ab[j] * S + ub[j]; }
    }
}
__device__ void phase_scan2(const Params& p) {
    const int tid = otid();
    const int G = gridDim.x, b = blockIdx.x;
    int u_lo, u_hi, u_st;
    if (G == 256) { if (b < 128) { u_lo = b; u_hi = b + 1; u_st = 1; } else { u_lo = 128 + (b - 128) * 8; u_hi = u_lo + 8; u_st = 1; } }
    else { u_lo = b; u_hi = 1152; u_st = G; }
    for (int u = u_lo; u < u_hi; u += u_st) {
        int ch, blk; if (u < 128) { ch = u >> 3; blk = u & 7; } else { ch = 16 + ((u - 128) >> 3); blk = (u - 128) & 7; }
        int n, gcb, h, d, bidx; bool sample;
        if (ch < 16) { sample = true; bidx = ch >> 3; h = (ch >> 1) & 3; d = ch & 1; n = 32; gcb = 64 + bidx * 32; }
        else { const int cp = ch - 16; sample = false; bidx = cp >> 3; h = (cp >> 1) & 3; d = cp & 1; n = 4; gcb = bidx * 4; }
        const int e4 = blk * 512 + tid, v = e4 >> 5, k0 = (e4 & 31) * 4;
        f32x4 S = {0.f, 0.f, 0.f, 0.f};
        const size_t soff = ((size_t)((bidx * 2 + d) * 4 + h) * 128) * 128;
        if (sample) {
#pragma unroll
            for (int j = 0; j < 4; ++j) S[j] = p.in[2][soff + (size_t)(k0 + j) * 128 + v];
            scan2_run<16>(p, gcb, n, h, d, v, k0, S);
        } else {
            scan2_run<4>(p, gcb, n, h, d, v, k0, S);
            float* o = p.out + OUT_STATE_OFF + soff;
#pragma unroll
            for (int j = 0; j < 4; ++j) o[(size_t)(k0 + j) * 128 + v] = S[j];
        }
    }
}

struct S3Regs { u32x4 rq[2], rk[2], rl[2], rv[2], rs[4]; };
__device__ __forceinline__ void s3_load(const Params& p, int item, int d, int tid, S3Regs& R) {
    const int gc = item >> 2, h = item & 3, t0 = gc * 64;
    const bf16_t* Qg = (const bf16_t*)(p.ws + WS_Q) + h * 128;
    const bf16_t* VI = (const bf16_t*)(p.ws + WS_VI) + h * 128;
    const bf16_t* KK = (const bf16_t*)(p.ws + (d == 0 ? WS_KF : WS_KB)) + h * 128;
    const bf16_t* LL = (const bf16_t*)(p.ws + (d == 0 ? WS_LF : WS_LFB)) + h * 128;
    const bf16_t* Sg = sin_ptr(p.ws, (size_t)(item * 2 + d));
#pragma unroll
    for (int i = 0; i < 2; ++i) { const int idx = tid + 512 * i, j = idx >> 4, c8 = idx & 15, loc = d == 0 ? j : 63 - j; const size_t go = (size_t)(t0 + loc) * 512 + c8 * 8;
        R.rq[i] = __builtin_nontemporal_load((const u32x4*)(Qg + go)); R.rk[i] = __builtin_nontemporal_load((const u32x4*)(KK + go)); R.rl[i] = __builtin_nontemporal_load((const u32x4*)(LL + go)); R.rv[i] = __builtin_nontemporal_load((const u32x4*)(VI + go)); }
#pragma unroll
    for (int i = 0; i < 4; ++i) { const int idx = tid + 512 * i, v = idx >> 4, c8 = idx & 15; R.rs[i] = *(const u32x4*)(Sg + v * 128 + c8 * 8); }
}
__device__ __forceinline__ void scan3_item(const Params& p, LAS unsigned char* lds, int item, int next_item, S3Regs& R) {
    const int tid = otid(), lane = tid & 63, wid = tid >> 6, fr = lane & 15, fq = lane >> 4;
    const int gc = item >> 2, h = item & 3, t0 = gc * 64;
    LAS bf16_t* QH = (LAS bf16_t*)lds;
    LAS bf16_t* KH = (LAS bf16_t*)(lds + 17408);
    LAS bf16_t* QT = (LAS bf16_t*)(lds + 34816);
    LAS bf16_t* VT = (LAS bf16_t*)(lds + 52224);
    LAS bf16_t* PP = (LAS bf16_t*)(lds + 70656);
    LAS bf16_t* ST = (LAS bf16_t*)(lds + 79872);
    LAS float* OO = (LAS float*)(lds + 114688);
    LAS float* QS = (LAS float*)(lds + 148480);
    const bf16_t* Qg = (const bf16_t*)(p.ws + WS_Q) + h * 128;
    const bf16_t* VI = (const bf16_t*)(p.ws + WS_VI) + h * 128;
#pragma unroll
    for (int d = 0; d < 2; ++d) {
        const bf16_t* KK = (const bf16_t*)(p.ws + (d == 0 ? WS_KF : WS_KB)) + h * 128;
        const bf16_t* LL = (const bf16_t*)(p.ws + (d == 0 ? WS_LF : WS_LFB)) + h * 128;
        const int k = tid & 127, q4 = tid >> 7;
        {
#pragma unroll
            for (int i = 0; i < 2; ++i) { const int idx = tid + 512 * i, j = idx >> 4, c8 = idx & 15;
                *(LAS u32x4*)(QH + j * 136 + c8 * 8) = R.rq[i]; *(LAS u32x4*)(KH + j * 136 + c8 * 8) = R.rk[i]; *(LAS u32x4*)(QT + j * 136 + c8 * 8) = R.rl[i];
                const u32x4 w = R.rv[i]; LAS bf16_t* o = VT + (c8 * 8) * 72 + j;
                o[0 * 72] = (bf16_t)(w.x & 0xffff); o[1 * 72] = (bf16_t)(w.x >> 16); o[2 * 72] = (bf16_t)(w.y & 0xffff); o[3 * 72] = (bf16_t)(w.y >> 16);
                o[4 * 72] = (bf16_t)(w.z & 0xffff); o[5 * 72] = (bf16_t)(w.z >> 16); o[6 * 72] = (bf16_t)(w.w & 0xffff); o[7 * 72] = (bf16_t)(w.w >> 16); }
#pragma unroll
            for (int i = 0; i < 4; ++i) { const int idx = tid + 512 * i, v = idx >> 4, c8 = idx & 15; *(LAS u32x4*)(ST + v * 136 + c8 * 8) = R.rs[i]; }
            if (d == 0) s3_load(p, item, 1, tid, R); else if (next_item >= 0) s3_load(p, next_item, 0, tid, R);
        }
        __syncthreads();
        float lf[16]; float qsum = 0.f;
#pragma unroll
        for (int i = 0; i < 16; ++i) { lf[i] = bf2f(QT[(q4 * 16 + i) * 136 + k]); qsum += lf[i]; }
        QS[q4 * 128 + k] = qsum;
        __syncthreads();
        {
            float run = 0.f;
#pragma unroll
            for (int q = 0; q < 4; ++q) run += (q < q4) ? QS[q * 128 + k] : 0.f;
            const float bmid = QS[k] + QS[128 + k];
#pragma unroll
            for (int i = 0; i < 16; ++i) {
                const int j = q4 * 16 + i;
                run += lf[i];
                const float qv = bf2f(QH[j * 136 + k]), kv = bf2f(KH[j * 136 + k]);
                const float e1 = __expf(fminf(run - bmid, 80.f)), e2 = __expf(fminf(bmid - run, 80.f)), e3 = __expf(run);
                QH[j * 136 + k] = f2bf(qv * e1); KH[j * 136 + k] = f2bf(kv * e2); QT[j * 136 + k] = f2bf(qv * e3);
            }
        }
        __syncthreads();
        {
#pragma unroll
            for (int q = 0; q < 2; ++q) {
                const int id = wid * 2 + q, ti = id >> 2, si = id & 3;
                f32x4 acc = {0.f, 0.f, 0.f, 0.f};
                if (si <= ti) {
#pragma unroll
                    for (int ks = 0; ks < 4; ++ks) {
                        const bf16x8 a = *(const LAS bf16x8*)(KH + (16 * si + fr) * 136 + ks * 32 + fq * 8);
                        const bf16x8 b = *(const LAS bf16x8*)(QH + (16 * ti + fr) * 136 + ks * 32 + fq * 8);
                        acc = MFMA16(a, b, acc);
                    }
                }
                const int t = 16 * ti + fr, s = 16 * si + 4 * fq;
                u32x2 w; w.x = cvt_pk_bf16(s + 0 <= t ? acc[0] : 0.f, s + 1 <= t ? acc[1] : 0.f); w.y = cvt_pk_bf16(s + 2 <= t ? acc[2] : 0.f, s + 3 <= t ? acc[3] : 0.f);
                *(LAS u32x2*)(PP + t * 72 + s) = w;
            }
        }
        __syncthreads();
        {
            const int tt = wid & 3, vg = wid >> 2;
            bf16x8 bp[2], bq[4];
#pragma unroll
            for (int ks = 0; ks < 2; ++ks) bp[ks] = *(const LAS bf16x8*)(PP + (16 * tt + fr) * 72 + ks * 32 + fq * 8);
#pragma unroll
            for (int ks = 0; ks < 4; ++ks) bq[ks] = *(const LAS bf16x8*)(QT + (16 * tt + fr) * 136 + ks * 32 + fq * 8);
            const int t = 16 * tt + fr, loc = d == 0 ? t : 63 - t;
#pragma unroll
            for (int q = 0; q < 4; ++q) {
                const int vt = vg * 4 + q;
                f32x4 acc = {0.f, 0.f, 0.f, 0.f};
#pragma unroll
                for (int ks = 0; ks < 2; ++ks) { const bf16x8 a = *(const LAS bf16x8*)(VT + (16 * vt + fr) * 72 + ks * 32 + fq * 8); acc = MFMA16(a, bp[ks], acc); }
#pragma unroll
                for (int ks = 0; ks < 4; ++ks) { const bf16x8 a = *(const LAS bf16x8*)(ST + (16 * vt + fr) * 136 + ks * 32 + fq * 8); acc = MFMA16(a, bq[ks], acc); }
                LAS f32x4* o = (LAS f32x4*)(OO + loc * 132 + 16 * vt + 4 * fq);
                if (d == 0) *o = acc; else *o = *o + acc;
            }
        }
        __syncthreads();
    }
    {
        const int t = tid >> 3, part = tid & 7;
        f32x4 o[4]; float ss = 0.f;
#pragma unroll
        for (int i = 0; i < 4; ++i) { o[i] = *(const LAS f32x4*)(OO + t * 132 + part * 16 + i * 4); ss += o[i][0] * o[i][0] + o[i][1] * o[i][1] + o[i][2] * o[i][2] + o[i][3] * o[i][3]; }
        ss += __shfl_xor(ss, 1, 64); ss += __shfl_xor(ss, 2, 64); ss += __shfl_xor(ss, 4, 64);
        const float rstd = rsqrtf(ss * (1.f / 128.f) + EPSN);
        const float* ng = p.in[13] + h * 128 + part * 16;
        const bf16_t* SG = (const bf16_t*)(p.ws + WS_SG) + (size_t)(t0 + t) * 512 + h * 128 + part * 16;
        bf16_t* YB = (bf16_t*)(p.ws + WS_YA) + (size_t)(t0 + t) * 1024 + 512 + h * 128 + part * 16;
        const u32x4 s0 = __builtin_nontemporal_load((const u32x4*)SG), s1 = __builtin_nontemporal_load((const u32x4*)(SG + 8));
        const f32x4 n0 = *(const f32x4*)ng, n1 = *(const f32x4*)(ng + 4), n2 = *(const f32x4*)(ng + 8), n3 = *(const f32x4*)(ng + 12);
        u32x4 w0, w1;
        w0.x = cvt_pk_bf16(o[0][0] * rstd * n0[0] * bflo(s0.x), o[0][1] * rstd * n0[1] * bfhi(s0.x));
        w0.y = cvt_pk_bf16(o[0][2] * rstd * n0[2] * bflo(s0.y), o[0][3] * rstd * n0[3] * bfhi(s0.y));
        w0.z = cvt_pk_bf16(o[1][0] * rstd * n1[0] * bflo(s0.z), o[1][1] * rstd * n1[1] * bfhi(s0.z));
        w0.w = cvt_pk_bf16(o[1][2] * rstd * n1[2] * bflo(s0.w), o[1][3] * rstd * n1[3] * bfhi(s0.w));
        w1.x = cvt_pk_bf16(o[2][0] * rstd * n2[0] * bflo(s1.x), o[2][1] * rstd * n2[1] * bfhi(s1.x));
        w1.y = cvt_pk_bf16(o[2][2] * rstd * n2[2] * bflo(s1.y), o[2][3] * rstd * n2[3] * bfhi(s1.y));
        w1.z = cvt_pk_bf16(o[3][0] * rstd * n3[0] * bflo(s1.z), o[3][1] * rstd * n3[1] * bfhi(s1.z));
        w1.w = cvt_pk_bf16(o[3][2] * rstd * n3[2] * bflo(s1.w), o[3][3] * rstd * n3[3] * bfhi(s1.w));
        *(u32x4*)YB = w0; *(u32x4*)(YB + 8) = w1;
    }
    __syncthreads();
}

__device__ __forceinline__ int fkey(float x) { const int b = __float_as_int(x); return b ^ ((b >> 31) & 0x7fffffff); }
#define CE(a, b) do { const int _h = max((a), (b)), _l = min((a), (b)); (a) = _h; (b) = _l; } while (0)
#define SORT16(L) do { CE(L[0], L[1]); CE(L[2], L[3]); CE(L[0], L[2]); CE(L[1], L[3]); CE(L[1], L[2]); CE(L[4], L[5]); CE(L[6], L[7]); CE(L[4], L[6]); CE(L[5], L[7]); CE(L[5], L[6]); CE(L[0], L[4]); CE(L[2], L[6]); CE(L[2], L[4]); CE(L[1], L[5]); CE(L[3], L[7]); CE(L[3], L[5]); CE(L[1], L[2]); CE(L[3], L[4]); CE(L[5], L[6]); CE(L[8], L[9]); CE(L[10], L[11]); CE(L[8], L[10]); CE(L[9], L[11]); CE(L[9], L[10]); CE(L[12], L[13]); CE(L[14], L[15]); CE(L[12], L[14]); CE(L[13], L[15]); CE(L[13], L[14]); CE(L[8], L[12]); CE(L[10], L[14]); CE(L[10], L[12]); CE(L[9], L[13]); CE(L[11], L[15]); CE(L[11], L[13]); CE(L[9], L[10]); CE(L[11], L[12]); CE(L[13], L[14]); CE(L[0], L[8]); CE(L[4], L[12]); CE(L[4], L[8]); CE(L[2], L[10]); CE(L[6], L[14]); CE(L[6], L[10]); CE(L[2], L[4]); CE(L[6], L[8]); CE(L[10], L[12]); CE(L[1], L[9]); CE(L[5], L[13]); CE(L[5], L[9]); CE(L[3], L[11]); CE(L[7], L[15]); CE(L[7], L[11]); CE(L[3], L[5]); CE(L[7], L[9]); CE(L[11], L[13]); CE(L[1], L[2]); CE(L[3], L[4]); CE(L[5], L[6]); CE(L[7], L[8]); CE(L[9], L[10]); CE(L[11], L[12]); CE(L[13], L[14]); } while (0)
#define MERGE_PRUNE(A, B) do { _Pragma("unroll") for (int _i = 0; _i < 16; ++_i) A[_i] = max(A[_i], B[15 - _i]); \
    _Pragma("unroll") for (int _d = 8; _d > 0; _d >>= 1) _Pragma("unroll") for (int _i = 0; _i < 16; ++_i) if ((_i & _d) == 0) CE(A[_i], A[_i + _d]); } while (0)
__device__ void topk_item(const Params& p, LAS unsigned char* lds, int item) {
    const int tid = otid(), lane = tid & 63, wid = tid >> 6, fr = lane & 15, fq = lane >> 4;
    const int tt = item >> 3, h = item & 7, T0 = tt * 128;
    LAS bf16_t* KL = (LAS bf16_t*)lds;
    LAS int* MG = (LAS int*)lds;
    LAS float* SSH = (LAS float*)(lds + 34816);
    LAS float* RR = (LAS float*)(lds + 34816 + 66048);
    const bf16_t* QP = (const bf16_t*)(p.ws + WS_QP) + (size_t)(T0 + 16 * wid + fr) * 2048 + h * 256;
    const bf16_t* KE = (const bf16_t*)(p.ws + WS_KEYS) + (size_t)h * 2 * 16384;
    for (int ph = 0; ph < 2; ++ph) {
        {
            u32x4 kr[4]; bf16x8 bq[4];
#pragma unroll
            for (int i = 0; i < 4; ++i) { const int idx = tid + 512 * i, row = idx >> 4, sg = idx & 15; kr[i] = *(const u32x4*)(KE + ph * 16384 + row * 128 + sg * 8); }
#pragma unroll
            for (int ks = 0; ks < 4; ++ks) bq[ks] = *(const bf16x8*)(QP + ph * 128 + ks * 32 + fq * 8);
#pragma unroll
            for (int i = 0; i < 4; ++i) { const int idx = tid + 512 * i, row = idx >> 4, sg = idx & 15; *(LAS u32x4*)(KL + row * 136 + sg * 8) = kr[i]; }
            __syncthreads();
#pragma unroll
            for (int kt = 0; kt < 8; ++kt) {
                f32x4 acc = {0.f, 0.f, 0.f, 0.f};
#pragma unroll
                for (int ks = 0; ks < 4; ++ks) { const bf16x8 a = *(const LAS bf16x8*)(KL + (16 * kt + fr) * 136 + ks * 32 + fq * 8); acc = MFMA16(a, bq[ks], acc); }
                LAS float* o = SSH + (16 * wid + fr) * 129 + 16 * kt + 4 * fq; o[0] = acc[0]; o[1] = acc[1]; o[2] = acc[2]; o[3] = acc[3];
            }
        }
        __syncthreads();
        {
            const int row = tid & 127, sub = tid >> 7;
            LAS float* rp = SSH + row * 129;
            int L[16], B[16];
#pragma unroll
            for (int i = 0; i < 16; ++i) { const int j = sub * 32 + i; L[i] = (fkey(rp[j]) & ~127) | (127 - j); }
            SORT16(L);
#pragma unroll
            for (int i = 0; i < 16; ++i) { const int j = sub * 32 + 16 + i; B[i] = (fkey(rp[j]) & ~127) | (127 - j); }
            SORT16(B);
            MERGE_PRUNE(L, B);
            if (sub >= 2) {
#pragma unroll
                for (int i = 0; i < 16; ++i) MG[tid * 17 + i] = L[i];
            }
            __syncthreads();
            if (sub < 2) {
#pragma unroll
                for (int i = 0; i < 16; ++i) B[i] = MG[(tid + 256) * 17 + i];
                MERGE_PRUNE(L, B);
                if (sub == 1) {
#pragma unroll
                    for (int i = 0; i < 16; ++i) MG[tid * 17 + i] = L[i];
                }
            }
            __syncthreads();
            if (sub == 0) {
#pragma unroll
                for (int i = 0; i < 16; ++i) B[i] = MG[(tid + 128) * 17 + i];
                MERGE_PRUNE(L, B);
#pragma unroll
                for (int i = 0; i < 16; ++i) { const int idx = 127 - (L[i] & 127); RR[row * 65 + ph * 32 + i] = rp[idx]; RR[row * 65 + ph * 32 + 16 + i] = __int_as_float(idx); }
            }
        }
        __syncthreads();
    }
    if (tid < 128) {
        const int tok = tid;
        LAS float* row = RR + tok * 65;
        float v1[16], v2[16];
#pragma unroll
        for (int i = 0; i < 16; ++i) { v1[i] = row[i]; v2[i] = row[32 + i]; }
        int L[16];
#pragma unroll
        for (int i = 0; i < 16; ++i) L[i] = (int)0x80000000;
#pragma unroll
        for (int a = 0; a < 16; ++a)
#pragma unroll
            for (int b = 0; b < 16; ++b) {
                if ((a + 1) * (b + 1) <= 16) {
                    int nk = (fkey(v1[a] + v2[b]) & ~255) | (255 - (a * 16 + b));
#pragma unroll
                    for (int i = 0; i < 16; ++i) { const int hi = max(L[i], nk); nk = min(L[i], nk); L[i] = hi; }
                }
            }
        float tv[16]; int ti[16]; float mx = -3.0e38f;
#pragma unroll
        for (int i = 0; i < 16; ++i) { const int ab = 255 - (L[i] & 255), a = ab >> 4, b = ab & 15;
            tv[i] = row[a] + row[32 + b]; ti[i] = __float_as_int(row[16 + a]) * 128 + __float_as_int(row[48 + b]); mx = fmaxf(mx, tv[i]); }
        float sum = 0.f;
#pragma unroll
        for (int i = 0; i < 16; ++i) { tv[i] = __expf(tv[i] - mx); sum += tv[i]; }
        const float inv = 1.f / sum;
        int* IDX = (int*)(p.ws + WS_IDX) + (size_t)(T0 + tok) * 128 + h * 16;
        float* GW = (float*)(p.ws + WS_GW) + (size_t)(T0 + tok) * 128 + h * 16;
#pragma unroll
        for (int i = 0; i < 4; ++i) {
            *(int4*)(IDX + 4 * i) = make_int4(ti[4 * i], ti[4 * i + 1], ti[4 * i + 2], ti[4 * i + 3]);
            *(f32x4*)(GW + 4 * i) = (f32x4){tv[4 * i] * inv, tv[4 * i + 1] * inv, tv[4 * i + 2] * inv, tv[4 * i + 3] * inv};
        }
    }
    __syncthreads();
}

typedef float f32x2 __attribute__((ext_vector_type(2)));
#define CVT4(W, B) __builtin_amdgcn_cvt_scalef32_pk_f32_fp4((W), 1.0f, (B))
__device__ __forceinline__ float dot16_fp4(const u32x2 w, const f32x2 (&hx)[8]) {
    f32x2 s = CVT4(w.x, 0) * hx[0];
    s += CVT4(w.x, 1) * hx[1]; s += CVT4(w.x, 2) * hx[2]; s += CVT4(w.x, 3) * hx[3];
    s += CVT4(w.y, 0) * hx[4]; s += CVT4(w.y, 1) * hx[5]; s += CVT4(w.y, 2) * hx[6]; s += CVT4(w.y, 3) * hx[7];
    return s[0] + s[1];
}
__device__ __forceinline__ void axpy16_fp4(const u32x2 w, const float a, f32x2 (&acc)[8]) {
    const f32x2 a2 = {a, a};
    acc[0] += a2 * CVT4(w.x, 0); acc[1] += a2 * CVT4(w.x, 1); acc[2] += a2 * CVT4(w.x, 2); acc[3] += a2 * CVT4(w.x, 3);
    acc[4] += a2 * CVT4(w.y, 0); acc[5] += a2 * CVT4(w.y, 1); acc[6] += a2 * CVT4(w.y, 2); acc[7] += a2 * CVT4(w.y, 3);
}
#define PEER_LOAD(UW, VW, GL, EB) do { _Pragma("unroll") for (int q = 0; q < 8; ++q) { const int e = (EB) + q; \
        const int ie = (e < 64) ? __builtin_amdgcn_readlane(myi0, e & 63) : __builtin_amdgcn_readlane(myi1, e & 63); \
        UW[q] = *(const u32x2*)(UTAB + (size_t)ie * 512 + lane * 8); VW[q] = *(const u32x2*)(VTAB + (size_t)ie * 512 + lane * 8); } \
        GL = GW[(EB) + (lane >> 3)]; } while (0)
#define PEER_COMPUTE(UW, VW, GL) do { float dt[8]; _Pragma("unroll") for (int q = 0; q < 8; ++q) dt[q] = dot16_fp4(UW[q], hx); \
        float r4[4]; _Pragma("unroll") for (int i = 0; i < 4; ++i) { const float mine = hi32 ? dt[i + 4] : dt[i], oth = hi32 ? dt[i] : dt[i + 4]; r4[i] = mine + __shfl_xor(oth, 32, 64); } \
        float r2[2]; _Pragma("unroll") for (int i = 0; i < 2; ++i) { const float mine = hi16 ? r4[i + 2] : r4[i], oth = hi16 ? r4[i] : r4[i + 2]; r2[i] = mine + __shfl_xor(oth, 16, 64); } \
        float r1; { const float mine = hi8 ? r2[1] : r2[0], oth = hi8 ? r2[0] : r2[1]; r1 = mine + __shfl_xor(oth, 8, 64); } \
        r1 += __shfl_xor(r1, 4, 64); r1 += __shfl_xor(r1, 2, 64); r1 += __shfl_xor(r1, 1, 64); \
        const float al = gelu_t(r1 * (1.f / U_SCALE)) * GL; \
        _Pragma("unroll") for (int q = 0; q < 8; ++q) { asm volatile("" : "+v"(VW[q]) : "v"(al)); \
            axpy16_fp4(VW[q], __int_as_float(__builtin_amdgcn_readlane(__float_as_int(al), q * 8)), acc); } } while (0)
__device__ void phase_peer(const Params& p) {
    const int tid_ = otid(), lane = tid_ & 63, wid = tid_ >> 6;
    const bool hi32 = (lane & 32) != 0, hi16 = (lane & 16) != 0, hi8 = (lane & 8) != 0;
    const unsigned char* UTAB = (const unsigned char*)(p.ws + WS_UTAB);
    const unsigned char* VTAB = (const unsigned char*)(p.ws + WS_VTAB);
    const float* fg = p.in[22];
    for (int tk = blockIdx.x * 8 + wid; tk < NTOK; tk += gridDim.x * 8) {
        const bf16_t* hrow = (const bf16_t*)(p.ws + WS_H) + (size_t)tk * 1024 + lane * 16;
        const u32x4 ha = *(const u32x4*)hrow, hb = *(const u32x4*)(hrow + 8);
        f32x2 hx[8];
        hx[0] = (f32x2){bflo(ha.x), bfhi(ha.x)}; hx[1] = (f32x2){bflo(ha.y), bfhi(ha.y)}; hx[2] = (f32x2){bflo(ha.z), bfhi(ha.z)}; hx[3] = (f32x2){bflo(ha.w), bfhi(ha.w)};
        hx[4] = (f32x2){bflo(hb.x), bfhi(hb.x)}; hx[5] = (f32x2){bflo(hb.y), bfhi(hb.y)}; hx[6] = (f32x2){bflo(hb.z), bfhi(hb.z)}; hx[7] = (f32x2){bflo(hb.w), bfhi(hb.w)};
        const int* IDX = (const int*)(p.ws + WS_IDX) + (size_t)tk * 128;
        const float* GW = (const float*)(p.ws + WS_GW) + (size_t)tk * 128;
        const int myi0 = IDX[lane], myi1 = IDX[64 + lane];
        f32x2 acc[8];
#pragma unroll
        for (int i = 0; i < 8; ++i) acc[i] = (f32x2){0.f, 0.f};
        u32x2 uA[8], vA[8], uB[8], vB[8], uC[8], vC[8]; float gA, gB, gC;
#define SB_ __builtin_amdgcn_sched_barrier(0)
        PEER_LOAD(uA, vA, gA, 0); PEER_LOAD(uB, vB, gB, 8); SB_;
        PEER_LOAD(uC, vC, gC, 16); SB_; PEER_COMPUTE(uA, vA, gA); SB_;
        PEER_LOAD(uA, vA, gA, 24); SB_; PEER_COMPUTE(uB, vB, gB); SB_;
        PEER_LOAD(uB, vB, gB, 32); SB_; PEER_COMPUTE(uC, vC, gC); SB_;
        PEER_LOAD(uC, vC, gC, 40); SB_; PEER_COMPUTE(uA, vA, gA); SB_;
        PEER_LOAD(uA, vA, gA, 48); SB_; PEER_COMPUTE(uB, vB, gB); SB_;
        PEER_LOAD(uB, vB, gB, 56); SB_; PEER_COMPUTE(uC, vC, gC); SB_;
        PEER_LOAD(uC, vC, gC, 64); SB_; PEER_COMPUTE(uA, vA, gA); SB_;
        PEER_LOAD(uA, vA, gA, 72); SB_; PEER_COMPUTE(uB, vB, gB); SB_;
        PEER_LOAD(uB, vB, gB, 80); SB_; PEER_COMPUTE(uC, vC, gC); SB_;
        PEER_LOAD(uC, vC, gC, 88); SB_; PEER_COMPUTE(uA, vA, gA); SB_;
        PEER_LOAD(uA, vA, gA, 96); SB_; PEER_COMPUTE(uB, vB, gB); SB_;
        PEER_LOAD(uB, vB, gB, 104); SB_; PEER_COMPUTE(uC, vC, gC); SB_;
        PEER_LOAD(uC, vC, gC, 112); SB_; PEER_COMPUTE(uA, vA, gA); SB_;
        PEER_LOAD(uA, vA, gA, 120); SB_; PEER_COMPUTE(uB, vB, gB); SB_;
        PEER_COMPUTE(uC, vC, gC); SB_;
        PEER_COMPUTE(uA, vA, gA); SB_;
#undef SB_
        const float* xr = (const float*)(p.ws + WS_X1) + (size_t)tk * 1024 + lane * 16;
        const float* g2 = (const float*)(p.ws + WS_MOD) + mod_of_token(tk) * 6144 + 5 * 1024 + lane * 16;
        float x2[16]; float ss = 0.f;
#pragma unroll
        for (int q = 0; q < 4; ++q) {
            const f32x4 xv = *(const f32x4*)(xr + q * 4), gv = *(const f32x4*)(g2 + q * 4);
#pragma unroll
            for (int j = 0; j < 4; ++j) { const float v = xv[j] + gv[j] * acc[q * 2 + (j >> 1)][j & 1] * (1.f / V_SCALE); x2[q * 4 + j] = v; ss += v * v; }
        }
        ss = wave_sum(ss);
        const float rstd = rsqrtf(ss * (1.f / 1024.f) + EPSN);
        float* yo = p.out + (size_t)tk * 1024 + lane * 16;
#pragma unroll
        for (int q = 0; q < 4; ++q) {
            const f32x4 fv = *(const f32x4*)(fg + lane * 16 + q * 4);
            f32x4 y;
#pragma unroll
            for (int j = 0; j < 4; ++j) y[j] = x2[q * 4 + j] * rstd * fv[j];
            *(f32x4*)(yo + q * 4) = y;
        }
    }
}

constexpr int N_PHASES = 13;
__global__ void __launch_bounds__(NTHREADS, 2) mega_fwd(Params p) {
    extern __shared__ __attribute__((aligned(16))) unsigned char smem[];
    LAS unsigned char* lds = (LAS unsigned char*)smem;
    cg::grid_group grid = cg::this_grid();
    if (p.ph_lo < 0) grid.sync();
    volatile LAS unsigned* xst = (volatile LAS unsigned*)(lds + LDS_BYTES - 16);
    if (threadIdx.x == 0) { xst[0] = 0u; xst[1] = 0u; xst[2] = 0u; xst[3] = 0u; }
    __syncthreads();
    XcdBarrier xb = xcd_barrier_post((unsigned*)(p.ws + WS_BAR), xst);
    for (int ph = p.ph_lo; ph < p.ph_hi; ++ph) {
        if (ph > p.ph_lo && ph != 7) xcd_barrier(xb);
#ifdef ONLY_PHASE
        if (ph != ONLY_PHASE) continue;
#endif
#ifdef REPEAT_MASK
        for (int rep = 0; rep < (((REPEAT_MASK) >> ph) & 1) + 1; ++rep) {
        if (rep) xcd_barrier(xb);
#endif
        int gm = -1, gN = 0, gK = 0, gsplit = 0; size_t offA = 0, offB = 0;
        switch (ph) {
        case 0: phase_prep(p, lds); break;
        case 1: phase_norm1(p); break;
        case 2: gm = 0; offA = WS_H; offB = WS_WINT; gN = INW; gK = 1024; break;
        case 3: phase_mix1(p, lds); break;
        case 4: phase_scan2(p); break;
        case 5: if (gridDim.x == 256) {
                      S3Regs R; s3_load(p, blockIdx.x, 0, otid(), R);
                      scan3_item(p, lds, blockIdx.x, blockIdx.x + 256, R); scan3_item(p, lds, blockIdx.x + 256, -1, R);
                  } else { for (int it = blockIdx.x; it < 512; it += gridDim.x) { S3Regs R; s3_load(p, it, 0, otid(), R); scan3_item(p, lds, it, -1, R); } }
                  break;
        case 6: gm = 1; offA = WS_YA; offB = WS_WAT; gN = 1024; gK = 1024; break;
        case 7: break;
        case 8: gm = 3; offA = WS_PM; offB = WS_WOUTT; gN = 2048; gK = 512; gsplit = 4; break;
        case 9: phase_norm2(p); break;
        case 10: gm = 4; offA = WS_H; offB = WS_WQT; gN = 2048; gK = 1024; break;
        case 11: for (int it = blockIdx.x; it < 512; it += gridDim.x) topk_item(p, lds, it); break;
        case 12: phase_peer(p); break;
        }
        if (gridDim.x > 128 && blockIdx.x >= 128) {
            const int w = blockIdx.x - 128, nw = gridDim.x - 128;
            if (ph == 6) convert_tables(p, 0, 1024, w, nw);
        }
        if (gm >= 0) { EpiAll E; E.ws = p.ws; E.xp = p.in[0]; E.mode = gm; run_gemm(lds, (const bf16_t*)(p.ws + offA), (const bf16_t*)(p.ws + offB), NTOK, gN, gK, gsplit, (size_t)NTOK * 512 * 2, E); }
        if (ph == 2 && gridDim.x == 256 && blockIdx.x >= 192) transpose_all(p, (LAS float*)lds, 704, 1216, blockIdx.x - 192, 64);
#ifdef REPEAT_MASK
        }
#endif
    }
}

extern "C" void kernel_launch(void* const* d_in, const int* in_sizes, int n_in, void* d_out, int out_size, void* d_ws, size_t ws_size, hipStream_t stream) {
    static int grid = 0;
    if (grid == 0) {
        if (n_in != 23 || ws_size < WS_END) { fprintf(stderr, "kernel_launch: unexpected n_in %d / ws_size %zu (need %zu)\n", n_in, ws_size, (size_t)WS_END); grid = -1; return; }
        int dev = 0, cus = 0, per_cu = 0;
        hipGetDevice(&dev);
        hipDeviceGetAttribute(&cus, hipDeviceAttributeMultiprocessorCount, dev);
        if (hipFuncSetAttribute((const void*)mega_fwd, hipFuncAttributeMaxDynamicSharedMemorySize, LDS_BYTES) != hipSuccess) { fprintf(stderr, "kernel_launch: hipFuncSetAttribute failed\n"); grid = -1; return; }
        if (hipOccupancyMaxActiveBlocksPerMultiprocessor(&per_cu, (const void*)mega_fwd, NTHREADS, LDS_BYTES) != hipSuccess || per_cu < 1) { fprintf(stderr, "kernel_launch: occupancy query gave %d\n", per_cu); per_cu = 1; }
        (void)hipGetLastError();
        grid = cus * 1;
        fprintf(stderr, "kernel_launch: cus %d per_cu %d grid %d\n", cus, per_cu, grid);
    }
    if (grid < 0) return;
    Params p{};
    for (int i = 0; i < 23; ++i) p.in[i] = (const float*)d_in[i];
    p.out = (float*)d_out; p.ws = (unsigned char*)d_ws;
    if (hipMemsetAsync((char*)d_ws + WS_BAR, 0, XCD_BAR_WORDS * 4, stream) != hipSuccess) { fprintf(stderr, "kernel_launch: memset of the barrier words failed\n"); return; }
#if N_LAUNCH_MODE == 0
    p.ph_lo = 0; p.ph_hi = N_PHASES;
    void* args[] = {&p};
    hipError_t e = hipLaunchCooperativeKernel((const void*)mega_fwd, dim3(grid), dim3(NTHREADS), args, LDS_BYTES, stream);
    if (e != hipSuccess) fprintf(stderr, "cooperative launch failed: %s (grid %d)\n", hipGetErrorString(e), grid);
#else
    for (int ph = 0; ph < N_PHASES; ++ph) {
        p.ph_lo = ph; p.ph_hi = ph + 1;
        hipLaunchKernelGGL(mega_fwd, dim3(grid), dim3(NTHREADS), LDS_BYTES, stream, p);
    }
#endif
}
```

```cpp
#include <hip/hip_runtime.h>
#include <hip/hip_cooperative_groups.h>
#include <cstdio>
namespace cg = cooperative_groups;

#ifndef N_LAUNCH_MODE
#define N_LAUNCH_MODE 0
#endif

#define LAS __attribute__((address_space(3)))
typedef unsigned short bf16_t;
typedef short bf16x8 __attribute__((ext_vector_type(8)));
typedef float f32x4 __attribute__((ext_vector_type(4)));
typedef unsigned u32x4 __attribute__((ext_vector_type(4)));
typedef unsigned u32x2 __attribute__((ext_vector_type(2)));

constexpr int NTOK = 8192, NPROMPT = 4096, DM = 1024, INW = 5632;
constexpr int NTHREADS = 512;
constexpr int LDS_BYTES = 150 * 1024;
constexpr float EPSN = 1e-6f;
constexpr float U_SCALE = 56.f, V_SCALE = 20.f;
constexpr size_t OUT_STATE_OFF = (size_t)NTOK * DM;

constexpr size_t MB = 1024 * 1024;
constexpr size_t WS_WINT = 0;
constexpr size_t WS_WAT = WS_WINT + (size_t)INW * DM * 2;
constexpr size_t WS_WBT = WS_WAT + 1 * MB;
constexpr size_t WS_WOUTT = WS_WBT + 1 * MB;
constexpr size_t WS_WQT = WS_WOUTT + 2 * MB;
constexpr size_t WS_KEYS = WS_WQT + 4 * MB;
constexpr size_t WS_WSP = WS_KEYS + 512 * 1024;
constexpr size_t WS_MOD = WS_WSP + 128 * 1024;
constexpr size_t WS_LB = WS_MOD + 128 * 1024;
constexpr size_t WS_AV = WS_LB + 64 * 1024;
constexpr size_t WS_X0S = WS_AV + 512 * 1024;
constexpr size_t WS_H = WS_X0S + 16 * MB;
constexpr size_t WS_YA = WS_H + 16 * MB;
constexpr size_t WS_YB = WS_YA + 8 * MB;
constexpr size_t WS_RA = WS_YB + 8 * MB;
constexpr size_t WS_U = WS_RA, WS_GV = WS_RA + 8 * MB, WS_Q = WS_RA + 16 * MB, WS_KF = WS_RA + 24 * MB, WS_LF = WS_RA + 32 * MB,
                 WS_KB = WS_RA + 40 * MB, WS_LFB = WS_RA + 48 * MB, WS_VI = WS_RA + 56 * MB, WS_SG = WS_RA + 64 * MB;
constexpr size_t WS_XP0 = WS_RA;
constexpr size_t WS_PM = WS_RA + 32 * MB;
constexpr size_t WS_QP = WS_RA;
constexpr size_t WS_IDX = WS_RA + 32 * MB;
constexpr size_t WS_GW = WS_RA + 36 * MB;
constexpr size_t WS_RC = WS_RA + 72 * MB;
constexpr size_t WS_SA = WS_RC, WS_SB = WS_RC + 16 * MB;
constexpr size_t WS_XP1 = WS_RC;
constexpr size_t WS_RB = WS_RC + 32 * MB;
constexpr size_t WS_UT = WS_RB;
constexpr size_t WS_X1 = WS_RB;
constexpr size_t WS_UTAB = WS_RB + 32 * MB;
constexpr size_t WS_VTAB = WS_RB + 48 * MB;
constexpr size_t WS_SINA = WS_H;
constexpr size_t WS_SINB = WS_RA;
constexpr size_t WS_BAR = WS_RB + 64 * MB;
constexpr size_t WS_END = WS_BAR + 64 * 1024;

struct Params {
    const float* in[23];
    float* out;
    unsigned char* ws;
    int ph_lo, ph_hi;
};

__device__ __forceinline__ unsigned cvt_pk_bf16(float lo, float hi) { unsigned r; asm volatile("v_cvt_pk_bf16_f32 %0, %1, %2" : "=v"(r) : "v"(lo), "v"(hi)); return r; }
__device__ __forceinline__ bf16_t f2bf(float f) { return (bf16_t)(cvt_pk_bf16(f, 0.f) & 0xffffu); }
__device__ __forceinline__ float bf2f(bf16_t b) { return __uint_as_float(((unsigned)b) << 16); }
__device__ __forceinline__ float bflo(unsigned u) { return __uint_as_float(u << 16); }
__device__ __forceinline__ float bfhi(unsigned u) { return __uint_as_float(u & 0xffff0000u); }
__device__ __forceinline__ float frcp(float x) { return __builtin_amdgcn_rcpf(x); }
__device__ __forceinline__ float sigm(float x) { return frcp(1.f + __expf(-x)); }
__device__ __forceinline__ float gelu_t(float x) { const float u = 0.7978845608028654f * (x + 0.044715f * x * x * x); return x * frcp(1.f + __expf(-2.f * u)); }
__device__ __forceinline__ float wave_sum(float v) {
#pragma unroll
    for (int o = 32; o > 0; o >>= 1) v += __shfl_xor(v, o, 64);
    return v;
}
__device__ __forceinline__ int otid() { int t = threadIdx.x; asm volatile("" : "+v"(t)); return t; }
__device__ __forceinline__ int mod_of_token(int tk) { return tk < NPROMPT ? 0 : 1 + ((tk - NPROMPT) >> 11); }


#define XB_TMO      128
#define XB_XCNT(j)  (256  + 64 * (j))
#define XB_XSUB(j)  (1280 + 64 * (j))
#define XB_XGEN(j)  (2304 + 64 * (j))
#define XB_TOP      3328
#define XB_TOPGEN   3392
#define XCD_BAR_WORDS 3456
#define XB_SPIN_CAP (1u << 18)
__device__ __forceinline__ unsigned xb_ld(unsigned* p)              { return __hip_atomic_load(p, __ATOMIC_RELAXED, __HIP_MEMORY_SCOPE_AGENT); }
__device__ __forceinline__ unsigned xb_add(unsigned* p, unsigned v) { return __hip_atomic_fetch_add(p, v, __ATOMIC_RELAXED, __HIP_MEMORY_SCOPE_AGENT); }
__device__ __forceinline__ unsigned xb_xcc_id() { return (unsigned)__builtin_amdgcn_s_getreg((3 << 11) | 20) & 0xFu; }
#define XB_SPIN(cond, bar) do { unsigned _sp = 0; while (cond) { __builtin_amdgcn_s_sleep(1); \
    if ((++_sp & 255u) == 0u) { if (xb_ld(&(bar)[XB_TMO])) break; if (_sp > XB_SPIN_CAP) { atomicAdd(&(bar)[XB_TMO], 1u); break; } } } } while (0)
struct XcdBarrier { unsigned* bar; unsigned x; volatile LAS unsigned* st; };
__device__ __forceinline__ XcdBarrier xcd_barrier_post(unsigned* bar, volatile LAS unsigned* st) {
    XcdBarrier b; b.bar = bar; b.x = xb_xcc_id(); b.st = st;
    if (threadIdx.x == 0) (void)xb_add(&bar[XB_XCNT(b.x)], 1u);
    return b;
}
__device__ __forceinline__ void xcd_barrier_complete(unsigned* bar, unsigned x, unsigned& nloc, unsigned& nx) {
    const unsigned G = gridDim.x * gridDim.y * gridDim.z;
    unsigned sum, cnt, mine, sp = 0u;
    for (;;) {
        sum = 0u; cnt = 0u; mine = 0u;
#pragma unroll
        for (unsigned j = 0; j < 16; ++j) { const unsigned c = xb_ld(&bar[XB_XCNT(j)]); sum += c; cnt += (c > 0u) ? 1u : 0u; mine = (j == x) ? c : mine; }
        if (sum == G) break;
        __builtin_amdgcn_s_sleep(1);
        if ((++sp & 255u) == 0u) { if (xb_ld(&bar[XB_TMO])) break; if (sp > XB_SPIN_CAP) { atomicAdd(&bar[XB_TMO], 1u); break; } }
    }
    nloc = mine > 0u ? mine : 1u; nx = cnt > 0u ? cnt : 1u;
}
__device__ __forceinline__ void xcd_barrier(const XcdBarrier& b) {
    asm volatile("s_waitcnt vmcnt(0)" ::: "memory");
    __syncthreads();
    if (threadIdx.x == 0) {
        unsigned* bar = b.bar;
        __builtin_amdgcn_s_waitcnt(0);
        unsigned nloc = b.st[0], nx = b.st[1];
        if (nloc == 0u) { xcd_barrier_complete(bar, b.x, nloc, nx); b.st[0] = nloc; b.st[1] = nx; }
        const unsigned old = xb_add(&bar[XB_XSUB(b.x)], 1u);
        const unsigned gen = old / nloc;
        if (old + 1u == (gen + 1u) * nloc) {
            __builtin_amdgcn_fence(__ATOMIC_RELEASE, "agent");
            asm volatile("s_waitcnt vmcnt(0)" ::: "memory");
            const unsigned og = xb_add(&bar[XB_TOP], 1u);
            const unsigned tg = og / nx;
            if (og + 1u == (tg + 1u) * nx) xb_add(&bar[XB_TOPGEN], 1u);
            else XB_SPIN(xb_ld(&bar[XB_TOPGEN]) == tg, bar);
            __builtin_amdgcn_fence(__ATOMIC_ACQUIRE, "agent");
            xb_add(&bar[XB_XGEN(b.x)], 1u);
            asm volatile("s_waitcnt vmcnt(0)" ::: "memory");
        } else {
            XB_SPIN(xb_ld(&bar[XB_XGEN(b.x)]) == gen, bar);
            __builtin_amdgcn_fence(__ATOMIC_ACQUIRE, "agent");
            asm volatile("s_waitcnt vmcnt(0)" ::: "memory");
        }
    }
    __syncthreads();
}

namespace pg8 {
constexpr int BM = 256, BK = 64, HALF = 128, HTB = HALF * BK * 2, STAGE_BYTES = 8 * HTB, NXCD = 8, WGM = 8;
__host__ __device__ __forceinline__ int lds_byte(int r, int c) { const int st = (r >> 4) * 2 + (c >> 5), rr = r & 15, cc = c & 31, ob = rr * 64 + cc * 2; return st * 1024 + (ob ^ (((ob >> 9) & 1) << 5)); }
__host__ __device__ __forceinline__ void stage_rc(int b, int& R, int& C) { const int st = b / 1024, sb = b % 1024, swz = sb ^ (((sb >> 9) & 1) << 5); R = (st >> 1) * 16 + swz / 64; C = (st & 1) * 32 + (swz % 64) / 2; }
__host__ __device__ __forceinline__ int perm32(int rho) { const int n = rho >> 4, i = rho & 15; return 8 * (i >> 2) + 4 * n + (i & 3); }
struct Unit { int pm, pn; };
struct Gemm { const bf16_t* A; const bf16_t* Bt; int M, N, K; int asplit; size_t astride; };
struct StaticOrder {
    int nM, nN, nwg, G, c;
    __host__ __device__ void init(int M, int N, int G_, int c_) { nM = M / BM; nN = N / BM; nwg = nM * nN; G = G_; c = c_; }
    __host__ __device__ bool next(int i, Unit& u) const {
        const long L = (long)i * G + c; if (L >= nwg) return false;
        int wgid = (int)L; { const int q = nwg / NXCD, r = nwg % NXCD, xcd = wgid % NXCD, off = wgid / NXCD; wgid = (xcd < r ? xcd * (q + 1) : r * (q + 1) + (xcd - r) * q) + off; }
        const int nig = WGM * nN, gid = wgid / nig, fm = gid * WGM, gsz = (nM - fm) < WGM ? (nM - fm) : WGM;
        u.pm = fm + ((wgid % nig) % gsz); u.pn = (wgid % nig) / gsz; return true;
    }
    __device__ __forceinline__ void a_ready(const Unit&) const {}
    __device__ __forceinline__ void done(const Unit&) const {}
};

template <class Epi, class Sched, bool MID>
__device__ __forceinline__ void gemm_phase(LAS unsigned char* lds, const Gemm g, const Sched& S, const Epi& E) {
    const int tid = otid(), wid = __builtin_amdgcn_readfirstlane(tid >> 6), lane = tid & 63, wr = wid >> 2, wc = wid & 3, fr = lane & 15, fq = lane >> 4;
    const int K = g.K, nt = K / BK;
    unsigned voffA[2], voffB[2];
#pragma unroll
    for (int i = 0; i < 2; ++i) { int R, C; stage_rc(tid * 16 + i * 8192, R, C); const int Rb = Epi::PERM ? ((R & ~31) + perm32(R & 31)) : R;
        voffA[i] = (unsigned)(R * K + C) * 2u; voffB[i] = (unsigned)(Rb * K + C) * 2u; }
    const size_t kstep = (size_t)(BK * 2);
    const size_t hstep = (size_t)HALF * K * 2;
    const size_t tstep = 2 * hstep;
    const unsigned ldsw = (unsigned)wid * 1024u;
    const int aoff = lds_byte(wr * 64 + fr, fq * 8), boff = lds_byte(wc * 32 + fr, fq * 8);
#define PG8_SA(b, h) (((b) * 2 + (h)) * HTB)
#define PG8_SB(b, h) ((4 + (b) * 2 + (h)) * HTB)
#define PG8_STAGE(bufoff, gbase, voff) do { _Pragma("unroll") for (int _i = 0; _i < 2; ++_i) \
        __builtin_amdgcn_global_load_lds((const unsigned*)((const char*)(gbase) + (voff)[_i]), (LAS unsigned*)(lds + (bufoff) + ldsw + _i * 8192), 16, 0, 0); } while (0)
#define PG8_LDA(dst, b, h) do { _Pragma("unroll") for (int m = 0; m < 4; ++m) _Pragma("unroll") for (int k = 0; k < 2; ++k) dst[m][k] = *(const LAS bf16x8*)(lds + PG8_SA(b, h) + aoff + m * 2048 + k * 1024); } while (0)
#define PG8_LDB(dst, b, h) do { _Pragma("unroll") for (int n = 0; n < 2; ++n) _Pragma("unroll") for (int k = 0; k < 2; ++k) dst[n][k] = *(const LAS bf16x8*)(lds + PG8_SB(b, h) + boff + n * 2048 + k * 1024); } while (0)
#define PG8_MMA(ai, bj, At, Bt) do { __builtin_amdgcn_s_setprio(1); _Pragma("unroll") for (int m = 0; m < 4; ++m) _Pragma("unroll") for (int n = 0; n < 2; ++n) _Pragma("unroll") for (int k = 0; k < 2; ++k) \
        acc[ai][bj][m][n] = __builtin_amdgcn_mfma_f32_16x16x32_bf16(Bt[n][k], At[m][k], acc[ai][bj][m][n], 0, 0, 0); __builtin_amdgcn_s_setprio(0); } while (0)
#define PG8_WAIT_V(n) asm volatile("s_waitcnt vmcnt(" #n ")" ::: "memory")
#define PG8_WAIT_L(n) asm volatile("s_waitcnt lgkmcnt(" #n ")" ::: "memory")
#define PG8_BAR __builtin_amdgcn_s_barrier()
#define PG8_SCHED __builtin_amdgcn_sched_barrier(0)
#define PG8_KBODY(t) do { \
            const bool last = (t == nt - 2); \
            const char* a1 = cA + (size_t)(t + 1) * kstep; \
            const char* a2 = last ? nA : cA + (size_t)(t + 2) * kstep; const char* b2 = last ? nB : cB + (size_t)(t + 2) * kstep; \
            const char* a3 = a2 + kstep; const char* b3 = b2 + kstep; \
            if (last && has_next) S.a_ready(nxt); \
            PG8_LDB(B0, 0, 0); PG8_SCHED; PG8_LDA(At, 0, 0); PG8_STAGE(PG8_SA(1, 1), a1 + hstep, voffA); \
            PG8_WAIT_L(8); PG8_BAR; PG8_WAIT_L(0); PG8_MMA(0, 0, At, B0); PG8_BAR; PG8_SCHED; \
            PG8_LDB(B1, 0, 1); PG8_STAGE(PG8_SB(0, 0), b2, voffB); \
            PG8_BAR; PG8_WAIT_L(0); PG8_MMA(0, 1, At, B1); PG8_BAR; \
            PG8_LDA(At, 0, 1); PG8_STAGE(PG8_SA(0, 0), a2, voffA); \
            PG8_BAR; PG8_WAIT_L(0); PG8_MMA(1, 0, At, B0); PG8_BAR; PG8_SCHED; \
            PG8_STAGE(PG8_SB(0, 1), b2 + hstep, voffB); \
            PG8_WAIT_V(6); PG8_BAR; PG8_MMA(1, 1, At, B1); PG8_BAR; \
            PG8_LDB(B0, 1, 0); PG8_SCHED; PG8_LDA(At, 1, 0); PG8_STAGE(PG8_SA(0, 1), a2 + hstep, voffA); \
            PG8_WAIT_L(8); PG8_BAR; PG8_WAIT_L(0); PG8_MMA(0, 0, At, B0); PG8_BAR; PG8_SCHED; \
            PG8_LDB(B1, 1, 1); PG8_STAGE(PG8_SB(1, 0), b3, voffB); \
            PG8_BAR; PG8_WAIT_L(0); PG8_MMA(0, 1, At, B1); PG8_BAR; \
            PG8_LDA(At, 1, 1); PG8_STAGE(PG8_SA(1, 0), a3, voffA); \
            PG8_BAR; PG8_WAIT_L(0); PG8_MMA(1, 0, At, B0); PG8_BAR; PG8_SCHED; \
            PG8_STAGE(PG8_SB(1, 1), b3 + hstep, voffB); \
            PG8_WAIT_V(6); PG8_BAR; PG8_MMA(1, 1, At, B1); PG8_BAR; \
        } while (0)
    Unit cur, nxt; int ui = 0;
    if (!S.next(0, cur)) return;
    f32x4 acc[2][2][4][2];
#pragma unroll
    for (int a = 0; a < 2; ++a)
#pragma unroll
        for (int b = 0; b < 2; ++b)
#pragma unroll
            for (int m = 0; m < 4; ++m)
#pragma unroll
                for (int n = 0; n < 2; ++n) acc[a][b][m][n] = (f32x4){0.f, 0.f, 0.f, 0.f};
    bf16x8 At[4][2], B0[2][2], B1[2][2];
    const char* cA = (const char*)g.A + (size_t)cur.pm * tstep + (g.asplit ? (size_t)(cur.pn / g.asplit) * g.astride : 0); const char* cB = (const char*)g.Bt + (size_t)cur.pn * tstep;
    S.a_ready(cur);
    PG8_STAGE(PG8_SB(0, 0), cB, voffB); PG8_STAGE(PG8_SA(0, 0), cA, voffA); PG8_STAGE(PG8_SB(0, 1), cB + hstep, voffB); PG8_STAGE(PG8_SA(0, 1), cA + hstep, voffA);
    if (wr == 1) PG8_BAR;
    PG8_WAIT_V(4); PG8_BAR;
    PG8_STAGE(PG8_SB(1, 0), cB + kstep, voffB); PG8_STAGE(PG8_SA(1, 0), cA + kstep, voffA); PG8_STAGE(PG8_SB(1, 1), cB + hstep + kstep, voffB);
    PG8_WAIT_V(6); PG8_BAR;
    for (;;) {
        const bool has_next = S.next(ui + 1, nxt);
        const char* nA = has_next ? (const char*)g.A + (size_t)nxt.pm * tstep + (g.asplit ? (size_t)(nxt.pn / g.asplit) * g.astride : 0) : cA; const char* nB = has_next ? (const char*)g.Bt + (size_t)nxt.pn * tstep : cB;
        if constexpr (MID) {
            for (int t = 0; t < (nt >> 1); t += 2) PG8_KBODY(t);
            { const int t2 = otid(), l2 = t2 & 63, w2 = __builtin_amdgcn_readfirstlane(t2 >> 6); E.mid(acc, cur, w2 >> 2, w2 & 3, l2 & 15, l2 >> 4); }
            for (int t = (nt >> 1); t < nt; t += 2) PG8_KBODY(t);
        } else {
            for (int t = 0; t < nt; t += 2) PG8_KBODY(t);
        }
        { const int t2 = otid(), l2 = t2 & 63, w2 = __builtin_amdgcn_readfirstlane(t2 >> 6); E(acc, cur, w2 >> 2, w2 & 3, l2 & 15, l2 >> 4); }
        if (!has_next) break;
#pragma unroll
        for (int a = 0; a < 2; ++a)
#pragma unroll
            for (int b = 0; b < 2; ++b)
#pragma unroll
                for (int m = 0; m < 4; ++m)
#pragma unroll
                    for (int n = 0; n < 2; ++n) acc[a][b][m][n] = (f32x4){0.f, 0.f, 0.f, 0.f};
        cur = nxt; cA = nA; cB = nB; ++ui;
    }
    PG8_WAIT_V(0);
    if (wr == 0) PG8_BAR;
    PG8_BAR;
#undef PG8_KBODY
#undef PG8_SA
#undef PG8_SB
#undef PG8_STAGE
#undef PG8_LDA
#undef PG8_LDB
#undef PG8_MMA
#undef PG8_WAIT_V
#undef PG8_WAIT_L
#undef PG8_BAR
#undef PG8_SCHED
}
}

__device__ __forceinline__ u32x4 pack8(f32x4 a, f32x4 b) { u32x4 w; w.x = cvt_pk_bf16(a[0], a[1]); w.y = cvt_pk_bf16(a[2], a[3]); w.z = cvt_pk_bf16(b[0], b[1]); w.w = cvt_pk_bf16(b[2], b[3]); return w; }

struct FZ {
    mutable size_t goff;
    unsigned char* ws;
    mutable int seg, cbase;
    __device__ __forceinline__ void begin(const pg8::Unit& u) const {
        const int pn = u.pn;
        if (pn < 14) { seg = pn >> 1; cbase = seg * 512; } else if (pn < 18) { seg = 7; cbase = 3584; } else { seg = 8; cbase = 4608; }
    }
    __device__ __forceinline__ void emit(int r, int c, f32x4 v0, f32x4 v1) const {
        const int cl = c - cbase;
        if (seg == 0 || seg == 1) {
#pragma unroll
            for (int j = 0; j < 4; ++j) { v0[j] = gelu_t(v0[j]); v1[j] = gelu_t(v1[j]); }
            bf16_t* o = (bf16_t*)(ws + (seg == 0 ? WS_U : WS_GV)) + (size_t)r * 512 + cl; *(u32x4*)o = pack8(v0, v1);
        } else if (seg == 2 || seg == 5) {
            bf16_t* o = (bf16_t*)(ws + (seg == 2 ? WS_Q : WS_VI)) + (size_t)r * 512 + cl; *(u32x4*)o = pack8(v0, v1);
        } else if (seg == 3 || seg == 4) {
            const int d = seg - 3;
            const float* lbp = (const float*)(ws + WS_LB) + d * 512 + cl;
            const f32x4 l0 = *(const f32x4*)lbp, l1 = *(const f32x4*)(lbp + 4);
            f32x4 k0, k1, g0, g1;
#pragma unroll
            for (int j = 0; j < 4; ++j) {
                { const float z = v0[j], e = __expf(-fabsf(z)), inv = frcp(1.f + e), sa = inv, sb = e * inv, sg = z >= 0.f ? sa : sb, nsg = z >= 0.f ? sb : sa, lb = l0[j];
                  k0[j] = (1.f - lb) * nsg; g0[j] = __logf(lb + (1.f - lb) * sg); }
                { const float z = v1[j], e = __expf(-fabsf(z)), inv = frcp(1.f + e), sa = inv, sb = e * inv, sg = z >= 0.f ? sa : sb, nsg = z >= 0.f ? sb : sa, lb = l1[j];
                  k1[j] = (1.f - lb) * nsg; g1[j] = __logf(lb + (1.f - lb) * sg); }
            }
            bf16_t* ok = (bf16_t*)(ws + (d == 0 ? WS_KF : WS_KB)) + (size_t)r * 512 + cl; *(u32x4*)ok = pack8(k0, k1);
            bf16_t* ol = (bf16_t*)(ws + (d == 0 ? WS_LF : WS_LFB)) + (size_t)r * 512 + cl; *(u32x4*)ol = pack8(g0, g1);
        } else if (seg == 6) {
#pragma unroll
            for (int j = 0; j < 4; ++j) { v0[j] = v0[j] * sigm(v0[j]); v1[j] = v1[j] * sigm(v1[j]); }
            bf16_t* o = (bf16_t*)(ws + WS_SG) + (size_t)r * 512 + cl; *(u32x4*)o = pack8(v0, v1);
        } else {
#pragma unroll
            for (int j = 0; j < 4; ++j) { v0[j] = sigm(v0[j]); v1[j] = sigm(v1[j]); }
            bf16_t* o = (bf16_t*)(ws + (seg == 7 ? WS_SA : WS_SB)) + goff; *(u32x4*)o = pack8(v0, v1);
        }
    }
};
struct FAB {
    mutable size_t goff;
    unsigned char* ws;
    __device__ __forceinline__ void begin(const pg8::Unit&) const {}
    __device__ __forceinline__ void emit(int r, int c, f32x4 v0, f32x4 v1) const {
        const u32x4 s = *(const u32x4*)((const bf16_t*)(ws + WS_SB) + goff);
        f32x4 a, b;
        a[0] = v0[0] * bflo(s.x); a[1] = v0[1] * bfhi(s.x); a[2] = v0[2] * bflo(s.y); a[3] = v0[3] * bfhi(s.y);
        b[0] = v1[0] * bflo(s.z); b[1] = v1[1] * bfhi(s.z); b[2] = v1[2] * bflo(s.w); b[3] = v1[3] * bfhi(s.w);
        *(u32x4*)((bf16_t*)(ws + WS_PM) + (size_t)(c >> 9) * NTOK * 512 + (size_t)r * 512 + (c & 511)) = pack8(a, b);
    }
    __device__ __forceinline__ void scale(int r, int c, f32x4& v0, f32x4& v1) const {
        const u32x4 sa = *(const u32x4*)((const bf16_t*)(ws + WS_SA) + goff);
        const u32x4 sb = *(const u32x4*)((const bf16_t*)(ws + WS_SB) + goff);
        v0[0] *= bflo(sa.x) * frcp(bflo(sb.x)); v0[1] *= bfhi(sa.x) * frcp(bfhi(sb.x)); v0[2] *= bflo(sa.y) * frcp(bflo(sb.y)); v0[3] *= bfhi(sa.y) * frcp(bfhi(sb.y));
        v1[0] *= bflo(sa.z) * frcp(bflo(sb.z)); v1[1] *= bfhi(sa.z) * frcp(bfhi(sb.z)); v1[2] *= bflo(sa.w) * frcp(bflo(sb.w)); v1[3] *= bfhi(sa.w) * frcp(bfhi(sb.w));
    }
};
struct FOUT {
    mutable size_t goff;
    unsigned char* ws; const float* xp;
    __device__ __forceinline__ void begin(const pg8::Unit&) const {}
    __device__ __forceinline__ void emit(int r, int c, f32x4 v0, f32x4 v1) const {
        float* o = (float*)(ws + ((c >> 10) ? WS_XP1 : WS_XP0)) + (size_t)r * 1024 + (c & 1023);
        *(f32x4*)o = v0; *(f32x4*)(o + 4) = v1;
    }
};
struct FQ {
    mutable size_t goff;
    unsigned char* ws;
    __device__ __forceinline__ void begin(const pg8::Unit&) const {}
    __device__ __forceinline__ void emit(int r, int c, f32x4 v0, f32x4 v1) const {
        *(u32x4*)((bf16_t*)(ws + WS_QP) + (size_t)r * 2048 + c) = pack8(v0, v1);
    }
};

struct EpiAll {
    static constexpr bool PERM = true;
    unsigned char* ws; const float* xp; int mode;
    template <class F> __device__ __forceinline__ void run(const F& f, const f32x4 (&acc)[2][2][4][2], const pg8::Unit& u, int wr, int wc, int fr, int fq) const {
        const int pnadd = (mode == 0) ? 2 : 0;
        f.begin(u);
#pragma unroll
        for (int ai = 0; ai < 2; ++ai)
#pragma unroll
            for (int m = 0; m < 4; ++m)
#pragma unroll
                for (int bj = 0; bj < 2; ++bj) {
                    const int r = u.pm * 256 + ai * 128 + wr * 64 + m * 16 + fr, c = u.pn * 256 + bj * 128 + wc * 32 + 8 * fq;
                    f.goff = ((size_t)((u.pm * 4 + ((u.pn + pnadd) & 3)) * 16 + (ai * 8 + m * 2 + bj))) * 4096 + (size_t)((wr * 4 + wc) * 64 + fq * 16 + fr) * 8;
                    f.emit(r, c, acc[ai][bj][m][0], acc[ai][bj][m][1]);
                }
    }
    __device__ __forceinline__ void mid(f32x4 (&acc)[2][2][4][2], const pg8::Unit& u, int wr, int wc, int fr, int fq) const {
        if (mode != 1) return;
        FAB f; f.ws = ws;
#pragma unroll
        for (int ai = 0; ai < 2; ++ai)
#pragma unroll
            for (int m = 0; m < 4; ++m)
#pragma unroll
                for (int bj = 0; bj < 2; ++bj) {
                    const int r = u.pm * 256 + ai * 128 + wr * 64 + m * 16 + fr, c = u.pn * 256 + bj * 128 + wc * 32 + 8 * fq;
                    f.goff = ((size_t)((u.pm * 4 + (u.pn & 3)) * 16 + (ai * 8 + m * 2 + bj))) * 4096 + (size_t)((wr * 4 + wc) * 64 + fq * 16 + fr) * 8;
                    f.scale(r, c, acc[ai][bj][m][0], acc[ai][bj][m][1]);
                    __builtin_amdgcn_sched_barrier(0);
                }
    }
    __device__ __forceinline__ void operator()(const f32x4 (&acc)[2][2][4][2], const pg8::Unit& u, int wr, int wc, int fr, int fq) const {
        if (mode == 0) { FZ f; f.ws = ws; f.seg = 0; f.cbase = 0; run(f, acc, u, wr, wc, fr, fq); }
        else if (mode == 1) { FAB f; f.ws = ws; run(f, acc, u, wr, wc, fr, fq); }
        else if (mode == 3) { FOUT f; f.ws = ws; f.xp = xp; run(f, acc, u, wr, wc, fr, fq); }
        else { FQ f; f.ws = ws; run(f, acc, u, wr, wc, fr, fq); }
    }
};
__device__ __forceinline__ void run_gemm(LAS unsigned char* lds, const bf16_t* A, const bf16_t* Bt, int M, int N, int K, int asplit, size_t astride, const EpiAll& E) {
    pg8::Gemm g; g.A = A; g.Bt = Bt; g.M = M; g.N = N; g.K = K; g.asplit = asplit; g.astride = astride;
    pg8::StaticOrder S; S.init(M, N, (int)gridDim.x, (int)blockIdx.x);
    if (E.mode == 1) pg8::gemm_phase<EpiAll, pg8::StaticOrder, true>(lds, g, S, E); else pg8::gemm_phase<EpiAll, pg8::StaticOrder, false>(lds, g, S, E);
}

struct TrJob { const float* src; bf16_t* dst; int K, N, k0, n0, kd; };
__device__ __forceinline__ bool tr_job(const Params& p, int t, TrJob& j) {
    int ntn; j.kd = 0;
    if (t < 704) { j.src = p.in[8]; j.dst = (bf16_t*)(p.ws + WS_WINT); j.K = 1024; j.N = INW; ntn = 44; }
    else if (t < 768) { t -= 704; j.src = p.in[14]; j.dst = (bf16_t*)(p.ws + WS_WAT); j.K = 1024; j.N = 1024; ntn = 8; }
    else if (t < 832) { t -= 768; j.src = p.in[15]; j.dst = (bf16_t*)(p.ws + WS_WAT); j.K = 1024; j.N = 1024; ntn = 8; j.kd = 512; }
    else if (t < 960) { t -= 832; j.src = p.in[16]; j.dst = (bf16_t*)(p.ws + WS_WOUTT); j.K = 512; j.N = 1024; ntn = 8;
        if (t / ntn >= 8) { j.dst += 1024 * 512; j.kd = -512; } }
    else if (t < 1216) { t -= 960; j.src = p.in[18]; j.dst = (bf16_t*)(p.ws + WS_WQT); j.K = 1024; j.N = 2048; ntn = 16; }
    else return false;
    const int tk = t / ntn, tn = t - tk * ntn; j.k0 = tk * 64; j.n0 = tn * 128; return true;
}
__device__ __forceinline__ void tr_load(const TrJob& j, int tid, f32x4 (&r)[4]) {
#pragma unroll
    for (int i = 0; i < 4; ++i) { const int k = (tid >> 5) + 16 * i, c = (tid & 31) * 4; r[i] = __builtin_nontemporal_load((const f32x4*)(j.src + (size_t)(j.k0 + k) * j.N + j.n0 + c)); }
}
__device__ __forceinline__ void transpose_all(const Params& p, LAS float* tl, int t_lo, int t_hi, int w, int nw) {
    const int tid = otid();
    TrJob cur, nxt; f32x4 r[4];
    int t = t_lo + w; bool have = t < t_hi && tr_job(p, t, cur);
    if (have) tr_load(cur, tid, r);
    while (have) {
#pragma unroll
        for (int i = 0; i < 4; ++i) { const int k = (tid >> 5) + 16 * i, c = (tid & 31) * 4; LAS float* o = tl + k * 129 + c; o[0] = r[i][0]; o[1] = r[i][1]; o[2] = r[i][2]; o[3] = r[i][3]; }
        __syncthreads();
        t += nw; const bool hn = t < t_hi && tr_job(p, t, nxt);
        if (hn) tr_load(nxt, tid, r);
#pragma unroll
        for (int i = 0; i < 2; ++i) { const int idx = tid + 512 * i, n = idx >> 3, ks = idx & 7;
            float f[8];
#pragma unroll
            for (int q = 0; q < 8; ++q) f[q] = tl[(ks * 8 + q) * 129 + n];
            u32x4 w; w.x = cvt_pk_bf16(f[0], f[1]); w.y = cvt_pk_bf16(f[2], f[3]); w.z = cvt_pk_bf16(f[4], f[5]); w.w = cvt_pk_bf16(f[6], f[7]);
            *(u32x4*)(cur.dst + (size_t)(cur.n0 + n) * cur.K + cur.kd + cur.k0 + ks * 8) = w; }
        __syncthreads();
        cur = nxt; have = hn;
    }
}
__device__ __forceinline__ void convert_item(const float* __restrict__ src, bf16_t* __restrict__ dst, int item) {
    const size_t base = (size_t)item * 8192 + otid();
#pragma unroll 4
    for (int i = 0; i < 16; ++i) {
        const size_t q = base + (size_t)i * 512;
        const f32x4 v = *(const f32x4*)(src + q * 4);
        u32x2 w; w.x = cvt_pk_bf16(v[0], v[1]); w.y = cvt_pk_bf16(v[2], v[3]);
        *(u32x2*)(dst + q * 4) = w;
    }
}
__device__ __forceinline__ void convert_item_fp4(const float* __restrict__ src, unsigned* __restrict__ dst, int item, float scale) {
    const size_t base = (size_t)item * 4096 + otid();
#pragma unroll 1
    for (int hf = 0; hf < 2; ++hf) {
        f32x4 v[8];
#pragma unroll
        for (int i = 0; i < 4; ++i) { const float* sp = src + (base + (size_t)(hf * 4 + i) * 512) * 8;
            v[2 * i] = __builtin_nontemporal_load((const f32x4*)sp); v[2 * i + 1] = __builtin_nontemporal_load((const f32x4*)(sp + 4)); }
#pragma unroll
        for (int i = 0; i < 4; ++i) {
            f32x4 a = v[2 * i], b = v[2 * i + 1];
#pragma unroll
            for (int j = 0; j < 4; ++j) { a[j] = fminf(fmaxf(a[j] * scale, -6.f), 6.f); b[j] = fminf(fmaxf(b[j] * scale, -6.f), 6.f); }
            unsigned w = 0;
            w = __builtin_amdgcn_cvt_scalef32_pk_fp4_f32(w, a[0], a[1], 1.0f, 0);
            w = __builtin_amdgcn_cvt_scalef32_pk_fp4_f32(w, a[2], a[3], 1.0f, 1);
            w = __builtin_amdgcn_cvt_scalef32_pk_fp4_f32(w, b[0], b[1], 1.0f, 2);
            w = __builtin_amdgcn_cvt_scalef32_pk_fp4_f32(w, b[2], b[3], 1.0f, 3);
            dst[base + (size_t)(hf * 4 + i) * 512] = w;
        }
    }
}
__device__ void phase_prep(const Params& p, LAS unsigned char* lds) {
    const int tid = otid();
    LAS float* sl = (LAS float*)lds;
    LAS float* red = (LAS float*)(lds + 12288);
    LAS float* tl = (LAS float*)(lds + 20480);
    for (int i = tid; i < 3072; i += NTHREADS) {
        const int m = i >> 10, k = i & 1023;
        const float cv = (m == 0) ? p.in[4][k] : p.in[3][(m - 1) * 1024 + k];
        sl[i] = cv * sigm(cv);
    }
    __syncthreads();
    transpose_all(p, tl, 0, gridDim.x == 256 ? 704 : 1216, blockIdx.x, gridDim.x);
    constexpr int I4 = 0;
    constexpr int I5 = I4 + 192;
    constexpr int I6 = I5 + 8;
    constexpr int I7 = I6 + 2;
    constexpr int I8 = I7 + 1;
    for (int it = (blockIdx.x + 64) % gridDim.x; it < I8; it += gridDim.x) {
        if (false) {}
        else if (it < I5) {
            const int c0 = (it - I4) * 32, col = tid & 31, ks = tid >> 5;
            const float* w = p.in[5] + c0 + col;
            float a0 = 0.f, a1 = 0.f, a2 = 0.f;
#pragma unroll 16
            for (int i = 0; i < 64; ++i) { const int k = ks + 16 * i; const float wv = __builtin_nontemporal_load(w + (size_t)k * 6144); a0 += sl[k] * wv; a1 += sl[1024 + k] * wv; a2 += sl[2048 + k] * wv; }
            red[(ks * 3 + 0) * 32 + col] = a0; red[(ks * 3 + 1) * 32 + col] = a1; red[(ks * 3 + 2) * 32 + col] = a2;
            __syncthreads();
            if (tid < 96) {
                const int m = tid >> 5, cc = tid & 31; float s = p.in[6][c0 + cc];
#pragma unroll
                for (int q = 0; q < 16; ++q) s += red[(q * 3 + m) * 32 + cc];
                ((float*)(p.ws + WS_MOD))[m * 6144 + c0 + cc] = s;
            }
            __syncthreads();
        }
        else if (it < I6) convert_item(p.in[19], (bf16_t*)(p.ws + WS_KEYS), it - I5);
        else if (it < I7) convert_item(p.in[10], (bf16_t*)(p.ws + WS_WSP), it - I6);
        else {
            for (int i = tid; i < 1024; i += NTHREADS) ((float*)(p.ws + WS_LB))[i] = sigm(p.in[12][i] - p.in[12][1024 + i]);
        }
    }
}

__device__ __forceinline__ f32x4 pos_embed4(int pos, int lane, int i) {
    const float base = (i < 2) ? (float)(pos >> 6) : (float)(pos & 63);
    f32x4 r;
#pragma unroll
    for (int j = 0; j < 4; ++j) {
        const int d = lane * 4 + j;
        const float om = exp2f((float)d * (-13.287712379549449f / 256.0f));
        const float ang = base * om;
        r[j] = (i & 1) ? __cosf(ang) : __sinf(ang);
    }
    return r;
}
__device__ void phase_norm1(const Params& p) {
    const int tid_ = otid(), lane = tid_ & 63, wid = tid_ >> 6;
    const float* g1 = p.in[7];
    const int stride = gridDim.x * 8;
    for (int tkb = blockIdx.x * 8 + wid; tkb < NTOK; tkb += 4 * stride) {
        f32x4 xs[4][4];
#pragma unroll
        for (int q = 0; q < 4; ++q) { const int tk = tkb + q * stride;
            if (tk < NTOK) { const float* xr = tk < NPROMPT ? p.in[0] + (size_t)tk * 1024 : p.in[1] + (size_t)(tk - NPROMPT) * 1024;
#pragma unroll
                for (int i = 0; i < 4; ++i) xs[q][i] = __builtin_nontemporal_load((const f32x4*)(xr + lane * 4 + 256 * i)); } }
#pragma unroll
        for (int q = 0; q < 4; ++q) {
            const int tk = tkb + q * stride;
            if (tk >= NTOK) break;
            const float* mod = (const float*)(p.ws + WS_MOD) + mod_of_token(tk) * 6144;
            f32x4 x[4]; float ss = 0.f;
#pragma unroll
            for (int i = 0; i < 4; ++i) x[i] = xs[q][i];
            if (tk >= NPROMPT) {
                const int pos = (tk - NPROMPT) & 2047;
#pragma unroll
                for (int i = 0; i < 4; ++i) x[i] += pos_embed4(pos, lane, i);
            }
#pragma unroll
            for (int i = 0; i < 4; ++i) ss += x[i][0] * x[i][0] + x[i][1] * x[i][1] + x[i][2] * x[i][2] + x[i][3] * x[i][3];
            ss = wave_sum(ss);
            const float rstd = rsqrtf(ss * (1.f / 1024.f) + EPSN);
            bf16_t* ho = (bf16_t*)(p.ws + WS_H) + (size_t)tk * 1024;
#pragma unroll
            for (int i = 0; i < 4; ++i) {
                const int c = lane * 4 + 256 * i;
                const f32x4 g = *(const f32x4*)(g1 + c), sh = *(const f32x4*)(mod + c), sc = *(const f32x4*)(mod + 1024 + c);
                f32x4 h;
#pragma unroll
                for (int j = 0; j < 4; ++j) h[j] = x[i][j] * rstd * g[j] * (1.f + sc[j]) + sh[j];
                u32x2 w; w.x = cvt_pk_bf16(h[0], h[1]); w.y = cvt_pk_bf16(h[2], h[3]);
                *(u32x2*)(ho + c) = w;
            }
        }
    }
}
__device__ __forceinline__ void convert_tables(const Params& p, int lo, int hi, int w, int nw) {
    for (int it = lo + w; it < hi; it += nw) {
        if (it < 512) convert_item_fp4(p.in[20], (unsigned*)(p.ws + WS_UTAB), it, U_SCALE);
        else convert_item_fp4(p.in[21], (unsigned*)(p.ws + WS_VTAB), it - 512, V_SCALE);
    }
}
__device__ void phase_norm2(const Params& p) {
    const int tid_ = otid(), lane = tid_ & 63, wid = tid_ >> 6;
    const float* g2 = p.in[17];
    if (gridDim.x <= 128) convert_tables(p, 0, 1024, blockIdx.x, gridDim.x);
    const int stride = gridDim.x * 8;
    for (int tkb = blockIdx.x * 8 + wid; tkb < NTOK; tkb += 4 * stride) {
        f32x4 xs[4][4];
#pragma unroll
        for (int q = 0; q < 4; ++q) { const int tk = tkb + q * stride;
            if (tk < NTOK) { const float* p0 = (const float*)(p.ws + WS_XP0) + (size_t)tk * 1024; const float* p1 = (const float*)(p.ws + WS_XP1) + (size_t)tk * 1024;
                const float* xr = tk < NPROMPT ? p.in[0] + (size_t)tk * 1024 : p.in[1] + (size_t)(tk - NPROMPT) * 1024;
                const float* gp = (const float*)(p.ws + WS_MOD) + mod_of_token(tk) * 6144 + 2 * 1024;
                float* xo = (float*)(p.ws + WS_X1) + (size_t)tk * 1024;
#pragma unroll
                for (int i = 0; i < 4; ++i) { const int c = lane * 4 + 256 * i;
                    xs[q][i] = *(const f32x4*)(xr + c) + *(const f32x4*)(gp + c) * (*(const f32x4*)(p0 + c) + *(const f32x4*)(p1 + c));
                    if (tk >= NPROMPT) xs[q][i] += pos_embed4((tk - NPROMPT) & 2047, lane, i);
                    *(f32x4*)(xo + c) = xs[q][i]; } } }
#pragma unroll
        for (int q = 0; q < 4; ++q) {
            const int tk = tkb + q * stride;
            if (tk >= NTOK) break;
            const float* mod = (const float*)(p.ws + WS_MOD) + mod_of_token(tk) * 6144;
            float ss = 0.f;
#pragma unroll
            for (int i = 0; i < 4; ++i) ss += xs[q][i][0] * xs[q][i][0] + xs[q][i][1] * xs[q][i][1] + xs[q][i][2] * xs[q][i][2] + xs[q][i][3] * xs[q][i][3];
            ss = wave_sum(ss);
            const float rstd = rsqrtf(ss * (1.f / 1024.f) + EPSN);
            bf16_t* ho = (bf16_t*)(p.ws + WS_H) + (size_t)tk * 1024;
#pragma unroll
            for (int i = 0; i < 4; ++i) {
                const int c = lane * 4 + 256 * i;
                const f32x4 g = *(const f32x4*)(g2 + c), sh = *(const f32x4*)(mod + 3 * 1024 + c), sc = *(const f32x4*)(mod + 4 * 1024 + c);
                f32x4 h;
#pragma unroll
                for (int j = 0; j < 4; ++j) h[j] = xs[q][i][j] * rstd * g[j] * (1.f + sc[j]) + sh[j];
                u32x2 w; w.x = cvt_pk_bf16(h[0], h[1]); w.y = cvt_pk_bf16(h[2], h[3]);
                *(u32x2*)(ho + c) = w;
            }
        }
    }
}

#define MFMA16(a, b, c) __builtin_amdgcn_mfma_f32_16x16x32_bf16((a), (b), (c), 0, 0, 0)
__device__ void gmlp_item(const Params& p, LAS unsigned char* lds, int item) {
    const int tid = otid(), lane = tid & 63, wid = tid >> 6, fr = lane & 15, fq = lane >> 4;
    const int ck = item >> 2, g = item & 3, t0 = ck * 128;
    LAS bf16_t* AS = (LAS bf16_t*)lds;
    LAS bf16_t* VT = (LAS bf16_t*)(lds + 34816);
    LAS float* rs = (LAS float*)(lds + 69632);
    const bf16_t* GV = (const bf16_t*)(p.ws + WS_GV);
    {
        const int s = tid >> 2, part = tid & 3;
        const u32x4* rp = (const u32x4*)(GV + (size_t)(t0 + s) * 512 + part * 128);
        float ss = 0.f;
#pragma unroll
        for (int i = 0; i < 16; ++i) { const u32x4 w = rp[i];
            const float a0 = bflo(w.x), a1 = bfhi(w.x), a2 = bflo(w.y), a3 = bfhi(w.y), a4 = bflo(w.z), a5 = bfhi(w.z), a6 = bflo(w.w), a7 = bfhi(w.w);
            ss += a0 * a0 + a1 * a1 + a2 * a2 + a3 * a3 + a4 * a4 + a5 * a5 + a6 * a6 + a7 * a7; }
        ss += __shfl_xor(ss, 1, 64); ss += __shfl_xor(ss, 2, 64);
        if (part == 0) rs[s] = rsqrtf(ss * (1.f / 512.f) + EPSN);
    }
    {
        const bf16_t* W = (const bf16_t*)(p.ws + WS_WSP) + g * 16384;
#pragma unroll
        for (int i = 0; i < 4; ++i) { const int idx = tid + 512 * i, row = idx >> 4, sg = idx & 15;
            *(LAS u32x4*)(AS + row * 136 + sg * 8) = *(const u32x4*)(W + row * 128 + sg * 8); }
    }
    __syncthreads();
    {
        const float* ng = p.in[9] + g * 128;
#pragma unroll
        for (int i = 0; i < 4; ++i) { const int idx = tid + 512 * i, s = idx >> 4, c8 = idx & 15;
            const u32x4 w = *(const u32x4*)(GV + (size_t)(t0 + s) * 512 + g * 128 + c8 * 8);
            const float r = rs[s]; const f32x4 n0 = *(const f32x4*)(ng + c8 * 8), n1 = *(const f32x4*)(ng + c8 * 8 + 4);
            LAS bf16_t* o = VT + (c8 * 8) * 136 + s;
            o[0 * 136] = f2bf(bflo(w.x) * r * n0[0]); o[1 * 136] = f2bf(bfhi(w.x) * r * n0[1]);
            o[2 * 136] = f2bf(bflo(w.y) * r * n0[2]); o[3 * 136] = f2bf(bfhi(w.y) * r * n0[3]);
            o[4 * 136] = f2bf(bflo(w.z) * r * n1[0]); o[5 * 136] = f2bf(bfhi(w.z) * r * n1[1]);
            o[6 * 136] = f2bf(bflo(w.w) * r * n1[2]); o[7 * 136] = f2bf(bfhi(w.w) * r * n1[3]); }
    }
    __syncthreads();
    {
        bf16x8 bt[4];
#pragma unroll
        for (int ks = 0; ks < 4; ++ks) bt[ks] = *(const LAS bf16x8*)(AS + (16 * wid + fr) * 136 + ks * 32 + fq * 8);
        const int tl = 16 * wid + fr, tok = t0 + tl;
        const float bs = p.in[11][g * 128 + tl];
        const bf16_t* U = (const bf16_t*)(p.ws + WS_U) + (size_t)tok * 512 + g * 128;
        bf16_t* YA = (bf16_t*)(p.ws + WS_YA) + (size_t)tok * 1024 + g * 128;
#pragma unroll
        for (int ct = 0; ct < 8; ++ct) {
            f32x4 acc = {0.f, 0.f, 0.f, 0.f};
#pragma unroll
            for (int ks = 0; ks < 4; ++ks) { const bf16x8 a = *(const LAS bf16x8*)(VT + (16 * ct + fr) * 136 + ks * 32 + fq * 8); acc = MFMA16(a, bt[ks], acc); }
            const int c = 16 * ct + 4 * fq;
            const u32x2 uu = *(const u32x2*)(U + c);
            u32x2 w; w.x = cvt_pk_bf16(bflo(uu.x) * (acc[0] + bs), bfhi(uu.x) * (acc[1] + bs)); w.y = cvt_pk_bf16(bflo(uu.y) * (acc[2] + bs), bfhi(uu.y) * (acc[3] + bs));
            *(u32x2*)(YA + c) = w;
        }
    }
    __syncthreads();
}
struct S1Regs { u32x4 rk[2][2], rl[2][2], rv[2]; };
__device__ __forceinline__ void s1_load(const Params& p, int item, int tid, S1Regs& R) {
    const int gc = item >> 2, h = item & 3, t0 = gc * 64;
#pragma unroll
    for (int i = 0; i < 2; ++i) { const int idx = tid + 512 * i, s = idx >> 4, c8 = idx & 15; const size_t go = (size_t)(t0 + s) * 512 + h * 128 + c8 * 8;
        R.rk[0][i] = *(const u32x4*)((const bf16_t*)(p.ws + WS_KF) + go); R.rl[0][i] = *(const u32x4*)((const bf16_t*)(p.ws + WS_LF) + go);
        R.rk[1][i] = *(const u32x4*)((const bf16_t*)(p.ws + WS_KB) + go); R.rl[1][i] = *(const u32x4*)((const bf16_t*)(p.ws + WS_LFB) + go);
        R.rv[i] = *(const u32x4*)((const bf16_t*)(p.ws + WS_VI) + go); }
}
__device__ __forceinline__ void scan1_item(const Params& p, LAS unsigned char* lds, int item, int next_item, S1Regs& R) {
    const int tid = otid(), lane = tid & 63, wid = tid >> 6, fr = lane & 15, fq = lane >> 4;
    const int gc = item >> 2, h = item & 3, t0 = gc * 64;
    LAS bf16_t* VT = (LAS bf16_t*)lds;
    LAS bf16_t* KDT = (LAS bf16_t*)(lds + 18432);
    LAS bf16_t* KS = (LAS bf16_t*)(lds + 55296);
    LAS bf16_t* LS = (LAS bf16_t*)(lds + 90112);
    {
#pragma unroll
        for (int i = 0; i < 2; ++i) { const int idx = tid + 512 * i, s = idx >> 4, c8 = idx & 15;
#pragma unroll
            for (int d = 0; d < 2; ++d) { *(LAS u32x4*)(KS + (d * 64 + s) * 136 + c8 * 8) = R.rk[d][i]; *(LAS u32x4*)(LS + (d * 64 + s) * 136 + c8 * 8) = R.rl[d][i]; }
            const u32x4 w = R.rv[i]; LAS bf16_t* o = VT + (c8 * 8) * 72 + s;
            o[0 * 72] = (bf16_t)(w.x & 0xffff); o[1 * 72] = (bf16_t)(w.x >> 16); o[2 * 72] = (bf16_t)(w.y & 0xffff); o[3 * 72] = (bf16_t)(w.y >> 16);
            o[4 * 72] = (bf16_t)(w.z & 0xffff); o[5 * 72] = (bf16_t)(w.z >> 16); o[6 * 72] = (bf16_t)(w.w & 0xffff); o[7 * 72] = (bf16_t)(w.w >> 16); }
        if (next_item >= 0) s1_load(p, next_item, tid, R);
    }
    __syncthreads();
    if (tid < 256) {
        const int d = tid >> 7, k = tid & 127;
        LAS bf16_t* o = KDT + (d * 128 + k) * 72;
        float run = 0.f;
#pragma unroll 8
        for (int j = 63; j >= 0; --j) {
            const int loc = d == 0 ? j : 63 - j;
            const float kv = bf2f(KS[(d * 64 + loc) * 136 + k]), lf = bf2f(LS[(d * 64 + loc) * 136 + k]);
            o[loc] = f2bf(kv * __expf(run));
            run += lf;
        }
        ((float*)(p.ws + WS_AV))[(size_t)(item * 2 + d) * 128 + k] = __expf(run);
    }
    __syncthreads();
    {
        bf16x8 bv[2];
#pragma unroll
        for (int ks = 0; ks < 2; ++ks) bv[ks] = *(const LAS bf16x8*)(VT + (16 * wid + fr) * 72 + ks * 32 + fq * 8);
#pragma unroll
        for (int d = 0; d < 2; ++d) {
            float* UT = (float*)(p.ws + WS_UT) + (size_t)(item * 2 + d) * 16384 + (16 * wid + fr) * 128;
#pragma unroll
            for (int kt = 0; kt < 8; ++kt) {
                f32x4 acc = {0.f, 0.f, 0.f, 0.f};
#pragma unroll
                for (int ks = 0; ks < 2; ++ks) { const bf16x8 a = *(const LAS bf16x8*)(KDT + (d * 128 + 16 * kt + fr) * 72 + ks * 32 + fq * 8); acc = MFMA16(a, bv[ks], acc); }
                *(f32x4*)(UT + 16 * kt + 4 * fq) = acc;
            }
        }
    }
    __syncthreads();
}
__device__ void phase_mix1(const Params& p, LAS unsigned char* lds) {
    if (gridDim.x == 256) {
        S1Regs R; s1_load(p, blockIdx.x, otid(), R);
        gmlp_item(p, lds, blockIdx.x);
        scan1_item(p, lds, blockIdx.x, blockIdx.x + 256, R); scan1_item(p, lds, blockIdx.x + 256, -1, R);
    } else {
        for (int it = blockIdx.x; it < 256; it += gridDim.x) gmlp_item(p, lds, it);
        for (int it = blockIdx.x; it < 512; it += gridDim.x) { S1Regs R; s1_load(p, it, otid(), R); scan1_item(p, lds, it, -1, R); }
    }
}

__device__ __forceinline__ bf16_t* sin_ptr(unsigned char* ws, size_t si) { return si < 512 ? (bf16_t*)(ws + WS_SINA) + si * 16384 : (bf16_t*)(ws + WS_SINB) + (si - 512) * 16384; }
template <int NB>
__device__ __forceinline__ void scan2_run(const Params& p, int gcb, int n, int h, int d, int v, int k0, f32x4& S) {
    const float* __restrict__ UT = (const float*)(p.ws + WS_UT);
    const float* __restrict__ AV = (const float*)(p.ws + WS_AV);
    for (int i0 = 0; i0 < n; i0 += NB) {
        f32x4 ub[NB], ab[NB];
#pragma unroll
        for (int j = 0; j < NB; ++j) { const int ci = d ? n - 1 - (i0 + j) : (i0 + j); const size_t si = (size_t)((gcb + ci) * 4 + h) * 2 + d;
            ub[j] = *(const f32x4*)(UT + si * 16384 + v * 128 + k0); ab[j] = *(const f32x4*)(AV + si * 128 + k0); }
#pragma unroll
        for (int j = 0; j < NB; ++j) { const int ci = d ? n - 1 - (i0 + j) : (i0 + j); const size_t si = (size_t)((gcb + ci) * 4 + h) * 2 + d;
            u32x2 w; w.x = cvt_pk_bf16(S[0], S[1]); w.y = cvt_pk_bf16(S[2], S[3]);
            *(u32x2*)(sin_ptr(p.ws, si) + v * 128 + k0) = w;
            S = ab[j] * S + ub[j]; }
    }
}
__device__ __forceinline__ void scan2_prompt_chain(const Params& p, LAS unsigned char* lds, int cp, int tid) {
    const int bidx = cp >> 3, h = (cp >> 1) & 3, d = cp & 1, gcb = bidx * 4;
    const float* UT = (const float*)(p.ws + WS_UT);
    const float* AV = (const float*)(p.ws + WS_AV);
    const int vr = tid >> 5, k0 = (tid & 31) * 4;
    f32x4 ab[4], ub[8][4];
#pragma unroll
    for (int j = 0; j < 4; ++j) { const int ci = d ? 3 - j : j; const size_t si = (size_t)((gcb + ci) * 4 + h) * 2 + d;
        ab[j] = *(const f32x4*)(AV + si * 128 + k0);
#pragma unroll
        for (int i = 0; i < 8; ++i) ub[i][j] = *(const f32x4*)(UT + si * 16384 + (i * 16 + vr) * 128 + k0); }
    LAS float* T = (LAS float*)lds;
#pragma unroll
    for (int i = 0; i < 8; ++i) {
        f32x4 S = {0.f, 0.f, 0.f, 0.f};
#pragma unroll
        for (int j = 0; j < 4; ++j) { const int ci = d ? 3 - j : j; const size_t si = (size_t)((gcb + ci) * 4 + h) * 2 + d;
            u32x2 w; w.x = cvt_pk_bf16(S[0], S[1]); w.y = cvt_pk_bf16(S[2], S[3]);
            *(u32x2*)(sin_ptr(p.ws, si) + (i * 16 + vr) * 128 + k0) = w;
            S = ab[j] * S + ub[i][j]; }
#pragma unroll
        for (int e = 0; e < 4; ++e) T[(k0 + e) * 129 + i * 16 + vr] = S[e];
    }
    __syncthreads();
    float* o = p.out + OUT_STATE_OFF + ((size_t)((bidx * 2 + d) * 4 + h) * 128) * 128;
    const int kr = tid >> 2, seg = (tid & 3) * 32;
#pragma unroll
    for (int q = 0; q < 8; ++q) { LAS float* t = T + kr * 129 + seg + q * 4; *(f32x4*)(o + kr * 128 + seg + q * 4) = (f32x4){t[0], t[1], t[2], t[3]}; }
    __syncthreads();
}
__device__ void phase_scan2(const Params& p, LAS unsigned char* lds) {
    const int tid = otid();
    if (gridDim.x == 256 && blockIdx.x >= 128) { scan2_prompt_chain(p, lds, blockIdx.x - 128, tid); return; }
    const int G = gridDim.x, b = blockIdx.x;
    int u_lo, u_hi, u_st;
    if (G == 256) { if (b < 128) { u_lo = b; u_hi = b + 1; u_st = 1; } else { u_lo = 128 + (b - 128) * 8; u_hi = u_lo + 8; u_st = 1; } }
    else { u_lo = b; u_hi = 1152; u_st = G; }
    for (int u = u_lo; u < u_hi; u += u_st) {
        int ch, blk; if (u < 128) { ch = u >> 3; blk = u & 7; } else { ch = 16 + ((u - 128) >> 3); blk = (u - 128) & 7; }
        int n, gcb, h, d, bidx; bool sample;
        if (ch < 16) { sample = true; bidx = ch >> 3; h = (ch >> 1) & 3; d = ch & 1; n = 32; gcb = 64 + bidx * 32; }
        else { const int cp = ch - 16; sample = false; bidx = cp >> 3; h = (cp >> 1) & 3; d = cp & 1; n = 4; gcb = bidx * 4; }
        const int e4 = blk * 512 + tid, v = e4 >> 5, k0 = (e4 & 31) * 4;
        f32x4 S = {0.f, 0.f, 0.f, 0.f};
        const size_t soff = ((size_t)((bidx * 2 + d) * 4 + h) * 128) * 128;
        if (sample) {
#pragma unroll
            for (int j = 0; j < 4; ++j) S[j] = p.in[2][soff + (size_t)(k0 + j) * 128 + v];
            scan2_run<16>(p, gcb, n, h, d, v, k0, S);
        } else {
            scan2_run<4>(p, gcb, n, h, d, v, k0, S);
            float* o = p.out + OUT_STATE_OFF + soff;
#pragma unroll
            for (int j = 0; j < 4; ++j) o[(size_t)(k0 + j) * 128 + v] = S[j];
        }
    }
}

struct S3Regs { u32x4 rq[2], rk[2], rl[2], rv[2], rs[4]; };
__device__ __forceinline__ void s3_load(const Params& p, int item, int d, int tid, S3Regs& R) {
    const int gc = item >> 2, h = item & 3, t0 = gc * 64;
    const bf16_t* Qg = (const bf16_t*)(p.ws + WS_Q) + h * 128;
    const bf16_t* VI = (const bf16_t*)(p.ws + WS_VI) + h * 128;
    const bf16_t* KK = (const bf16_t*)(p.ws + (d == 0 ? WS_KF : WS_KB)) + h * 128;
    const bf16_t* LL = (const bf16_t*)(p.ws + (d == 0 ? WS_LF : WS_LFB)) + h * 128;
    const bf16_t* Sg = sin_ptr(p.ws, (size_t)(item * 2 + d));
#pragma unroll
    for (int i = 0; i < 2; ++i) { const int idx = tid + 512 * i, j = idx >> 4, c8 = idx & 15, loc = d == 0 ? j : 63 - j; const size_t go = (size_t)(t0 + loc) * 512 + c8 * 8;
        R.rq[i] = *(const u32x4*)(Qg + go); R.rk[i] = *(const u32x4*)(KK + go); R.rl[i] = *(const u32x4*)(LL + go); R.rv[i] = *(const u32x4*)(VI + go); }
#pragma unroll
    for (int i = 0; i < 4; ++i) { const int idx = tid + 512 * i, v = idx >> 4, c8 = idx & 15; R.rs[i] = *(const u32x4*)(Sg + v * 128 + c8 * 8); }
}
__device__ __forceinline__ void scan3_item(const Params& p, LAS unsigned char* lds, int item, int next_item, S3Regs& R) {
    const int tid = otid(), lane = tid & 63, wid = tid >> 6, fr = lane & 15, fq = lane >> 4;
    const int gc = item >> 2, h = item & 3, t0 = gc * 64;
    LAS bf16_t* QH = (LAS bf16_t*)lds;
    LAS bf16_t* KH = (LAS bf16_t*)(lds + 17408);
    LAS bf16_t* QT = (LAS bf16_t*)(lds + 34816);
    LAS bf16_t* VT = (LAS bf16_t*)(lds + 52224);
    LAS bf16_t* PP = (LAS bf16_t*)(lds + 70656);
    LAS bf16_t* ST = (LAS bf16_t*)(lds + 79872);
    LAS float* OO = (LAS float*)(lds + 114688);
    LAS float* QS = (LAS float*)(lds + 148480);
    const bf16_t* Qg = (const bf16_t*)(p.ws + WS_Q) + h * 128;
    const bf16_t* VI = (const bf16_t*)(p.ws + WS_VI) + h * 128;
#pragma unroll
    for (int d = 0; d < 2; ++d) {
        const bf16_t* KK = (const bf16_t*)(p.ws + (d == 0 ? WS_KF : WS_KB)) + h * 128;
        const bf16_t* LL = (const bf16_t*)(p.ws + (d == 0 ? WS_LF : WS_LFB)) + h * 128;
        const int k = tid & 127, q4 = tid >> 7;
        {
#pragma unroll
            for (int i = 0; i < 2; ++i) { const int idx = tid + 512 * i, j = idx >> 4, c8 = idx & 15;
                *(LAS u32x4*)(QH + j * 136 + c8 * 8) = R.rq[i]; *(LAS u32x4*)(KH + j * 136 + c8 * 8) = R.rk[i]; *(LAS u32x4*)(QT + j * 136 + c8 * 8) = R.rl[i];
                const u32x4 w = R.rv[i]; LAS bf16_t* o = VT + (c8 * 8) * 72 + j;
                o[0 * 72] = (bf16_t)(w.x & 0xffff); o[1 * 72] = (bf16_t)(w.x >> 16); o[2 * 72] = (bf16_t)(w.y & 0xffff); o[3 * 72] = (bf16_t)(w.y >> 16);
                o[4 * 72] = (bf16_t)(w.z & 0xffff); o[5 * 72] = (bf16_t)(w.z >> 16); o[6 * 72] = (bf16_t)(w.w & 0xffff); o[7 * 72] = (bf16_t)(w.w >> 16); }
#pragma unroll
            for (int i = 0; i < 4; ++i) { const int idx = tid + 512 * i, v = idx >> 4, c8 = idx & 15; *(LAS u32x4*)(ST + v * 136 + c8 * 8) = R.rs[i]; }
            if (d == 0) s3_load(p, item, 1, tid, R); else if (next_item >= 0) s3_load(p, next_item, 0, tid, R);
        }
        __syncthreads();
        float lf[16]; float qsum = 0.f;
#pragma unroll
        for (int i = 0; i < 16; ++i) { lf[i] = bf2f(QT[(q4 * 16 + i) * 136 + k]); qsum += lf[i]; }
        QS[q4 * 128 + k] = qsum;
        __syncthreads();
        {
            float run = 0.f;
#pragma unroll
            for (int q = 0; q < 4; ++q) run += (q < q4) ? QS[q * 128 + k] : 0.f;
            const float bmid = QS[k] + QS[128 + k];
#pragma unroll
            for (int i = 0; i < 16; ++i) {
                const int j = q4 * 16 + i;
                run += lf[i];
                const float qv = bf2f(QH[j * 136 + k]), kv = bf2f(KH[j * 136 + k]);
                const float e1 = __expf(fminf(run - bmid, 80.f)), e2 = __expf(fminf(bmid - run, 80.f)), e3 = __expf(run);
                QH[j * 136 + k] = f2bf(qv * e1); KH[j * 136 + k] = f2bf(kv * e2); QT[j * 136 + k] = f2bf(qv * e3);
            }
        }
        __syncthreads();
        {
#pragma unroll
            for (int q = 0; q < 2; ++q) {
                const int id = wid * 2 + q, ti = id >> 2, si = id & 3;
                f32x4 acc = {0.f, 0.f, 0.f, 0.f};
                if (si <= ti) {
#pragma unroll
                    for (int ks = 0; ks < 4; ++ks) {
                        const bf16x8 a = *(const LAS bf16x8*)(KH + (16 * si + fr) * 136 + ks * 32 + fq * 8);
                        const bf16x8 b = *(const LAS bf16x8*)(QH + (16 * ti + fr) * 136 + ks * 32 + fq * 8);
                        acc = MFMA16(a, b, acc);
                    }
                }
                const int t = 16 * ti + fr, s = 16 * si + 4 * fq;
                u32x2 w; w.x = cvt_pk_bf16(s + 0 <= t ? acc[0] : 0.f, s + 1 <= t ? acc[1] : 0.f); w.y = cvt_pk_bf16(s + 2 <= t ? acc[2] : 0.f, s + 3 <= t ? acc[3] : 0.f);
                *(LAS u32x2*)(PP + t * 72 + s) = w;
            }
        }
        __syncthreads();
        {
            const int tt = wid & 3, vg = wid >> 2;
            bf16x8 bp[2], bq[4];
#pragma unroll
            for (int ks = 0; ks < 2; ++ks) bp[ks] = *(const LAS bf16x8*)(PP + (16 * tt + fr) * 72 + ks * 32 + fq * 8);
#pragma unroll
            for (int ks = 0; ks < 4; ++ks) bq[ks] = *(const LAS bf16x8*)(QT + (16 * tt + fr) * 136 + ks * 32 + fq * 8);
            const int t = 16 * tt + fr, loc = d == 0 ? t : 63 - t;
#pragma unroll
            for (int q = 0; q < 4; ++q) {
                const int vt = vg * 4 + q;
                f32x4 acc = {0.f, 0.f, 0.f, 0.f};
#pragma unroll
                for (int ks = 0; ks < 2; ++ks) { const bf16x8 a = *(const LAS bf16x8*)(VT + (16 * vt + fr) * 72 + ks * 32 + fq * 8); acc = MFMA16(a, bp[ks], acc); }
#pragma unroll
                for (int ks = 0; ks < 4; ++ks) { const bf16x8 a = *(const LAS bf16x8*)(ST + (16 * vt + fr) * 136 + ks * 32 + fq * 8); acc = MFMA16(a, bq[ks], acc); }
                LAS f32x4* o = (LAS f32x4*)(OO + loc * 132 + 16 * vt + 4 * fq);
                if (d == 0) *o = acc; else *o = *o + acc;
            }
        }
        __syncthreads();
    }
    {
        const int t = tid >> 3, part = tid & 7;
        f32x4 o[4]; float ss = 0.f;
#pragma unroll
        for (int i = 0; i < 4; ++i) { o[i] = *(const LAS f32x4*)(OO + t * 132 + part * 16 + i * 4); ss += o[i][0] * o[i][0] + o[i][1] * o[i][1] + o[i][2] * o[i][2] + o[i][3] * o[i][3]; }
        ss += __shfl_xor(ss, 1, 64); ss += __shfl_xor(ss, 2, 64); ss += __shfl_xor(ss, 4, 64);
        const float rstd = rsqrtf(ss * (1.f / 128.f) + EPSN);
        const float* ng = p.in[13] + h * 128 + part * 16;
        const bf16_t* SG = (const bf16_t*)(p.ws + WS_SG) + (size_t)(t0 + t) * 512 + h * 128 + part * 16;
        bf16_t* YB = (bf16_t*)(p.ws + WS_YA) + (size_t)(t0 + t) * 1024 + 512 + h * 128 + part * 16;
        const u32x4 s0 = *(const u32x4*)SG, s1 = *(const u32x4*)(SG + 8);
        const f32x4 n0 = *(const f32x4*)ng, n1 = *(const f32x4*)(ng + 4), n2 = *(const f32x4*)(ng + 8), n3 = *(const f32x4*)(ng + 12);
        u32x4 w0, w1;
        w0.x = cvt_pk_bf16(o[0][0] * rstd * n0[0] * bflo(s0.x), o[0][1] * rstd * n0[1] * bfhi(s0.x));
        w0.y = cvt_pk_bf16(o[0][2] * rstd * n0[2] * bflo(s0.y), o[0][3] * rstd * n0[3] * bfhi(s0.y));
        w0.z = cvt_pk_bf16(o[1][0] * rstd * n1[0] * bflo(s0.z), o[1][1] * rstd * n1[1] * bfhi(s0.z));
        w0.w = cvt_pk_bf16(o[1][2] * rstd * n1[2] * bflo(s0.w), o[1][3] * rstd * n1[3] * bfhi(s0.w));
        w1.x = cvt_pk_bf16(o[2][0] * rstd * n2[0] * bflo(s1.x), o[2][1] * rstd * n2[1] * bfhi(s1.x));
        w1.y = cvt_pk_bf16(o[2][2] * rstd * n2[2] * bflo(s1.y), o[2][3] * rstd * n2[3] * bfhi(s1.y));
        w1.z = cvt_pk_bf16(o[3][0] * rstd * n3[0] * bflo(s1.z), o[3][1] * rstd * n3[1] * bfhi(s1.z));
        w1.w = cvt_pk_bf16(o[3][2] * rstd * n3[2] * bflo(s1.w), o[3][3] * rstd * n3[3] * bfhi(s1.w));
        *(u32x4*)YB = w0; *(u32x4*)(YB + 8) = w1;
    }
    __syncthreads();
}

__device__ __forceinline__ int fkey(float x) { const int b = __float_as_int(x); return b ^ ((b >> 31) & 0x7fffffff); }
#define CE(a, b) do { const int _h = max((a), (b)), _l = min((a), (b)); (a) = _h; (b) = _l; } while (0)
#define SORT16(L) do { CE(L[0], L[1]); CE(L[2], L[3]); CE(L[0], L[2]); CE(L[1], L[3]); CE(L[1], L[2]); CE(L[4], L[5]); CE(L[6], L[7]); CE(L[4], L[6]); CE(L[5], L[7]); CE(L[5], L[6]); CE(L[0], L[4]); CE(L[2], L[6]); CE(L[2], L[4]); CE(L[1], L[5]); CE(L[3], L[7]); CE(L[3], L[5]); CE(L[1], L[2]); CE(L[3], L[4]); CE(L[5], L[6]); CE(L[8], L[9]); CE(L[10], L[11]); CE(L[8], L[10]); CE(L[9], L[11]); CE(L[9], L[10]); CE(L[12], L[13]); CE(L[14], L[15]); CE(L[12], L[14]); CE(L[13], L[15]); CE(L[13], L[14]); CE(L[8], L[12]); CE(L[10], L[14]); CE(L[10], L[12]); CE(L[9], L[13]); CE(L[11], L[15]); CE(L[11], L[13]); CE(L[9], L[10]); CE(L[11], L[12]); CE(L[13], L[14]); CE(L[0], L[8]); CE(L[4], L[12]); CE(L[4], L[8]); CE(L[2], L[10]); CE(L[6], L[14]); CE(L[6], L[10]); CE(L[2], L[4]); CE(L[6], L[8]); CE(L[10], L[12]); CE(L[1], L[9]); CE(L[5], L[13]); CE(L[5], L[9]); CE(L[3], L[11]); CE(L[7], L[15]); CE(L[7], L[11]); CE(L[3], L[5]); CE(L[7], L[9]); CE(L[11], L[13]); CE(L[1], L[2]); CE(L[3], L[4]); CE(L[5], L[6]); CE(L[7], L[8]); CE(L[9], L[10]); CE(L[11], L[12]); CE(L[13], L[14]); } while (0)
#define MERGE_PRUNE(A, B) do { _Pragma("unroll") for (int _i = 0; _i < 16; ++_i) A[_i] = max(A[_i], B[15 - _i]); \
    _Pragma("unroll") for (int _d = 8; _d > 0; _d >>= 1) _Pragma("unroll") for (int _i = 0; _i < 16; ++_i) if ((_i & _d) == 0) CE(A[_i], A[_i + _d]); } while (0)
__device__ void topk_item(const Params& p, LAS unsigned char* lds, int item) {
    const int tid = otid(), lane = tid & 63, wid = tid >> 6, fr = lane & 15, fq = lane >> 4;
    const int tt = item >> 3, h = item & 7, T0 = tt * 128;
    LAS bf16_t* KL = (LAS bf16_t*)lds;
    LAS int* MG = (LAS int*)lds;
    LAS float* SSH = (LAS float*)(lds + 34816);
    LAS float* RR = (LAS float*)(lds + 34816 + 66048);
    const bf16_t* QP = (const bf16_t*)(p.ws + WS_QP) + (size_t)(T0 + 16 * wid + fr) * 2048 + h * 256;
    const bf16_t* KE = (const bf16_t*)(p.ws + WS_KEYS) + (size_t)h * 2 * 16384;
    for (int ph = 0; ph < 2; ++ph) {
        {
            u32x4 kr[4]; bf16x8 bq[4];
#pragma unroll
            for (int i = 0; i < 4; ++i) { const int idx = tid + 512 * i, row = idx >> 4, sg = idx & 15; kr[i] = *(const u32x4*)(KE + ph * 16384 + row * 128 + sg * 8); }
#pragma unroll
            for (int ks = 0; ks < 4; ++ks) bq[ks] = *(const bf16x8*)(QP + ph * 128 + ks * 32 + fq * 8);
#pragma unroll
            for (int i = 0; i < 4; ++i) { const int idx = tid + 512 * i, row = idx >> 4, sg = idx & 15; *(LAS u32x4*)(KL + row * 136 + sg * 8) = kr[i]; }
            __syncthreads();
#pragma unroll
            for (int kt = 0; kt < 8; ++kt) {
                f32x4 acc = {0.f, 0.f, 0.f, 0.f};
#pragma unroll
                for (int ks = 0; ks < 4; ++ks) { const bf16x8 a = *(const LAS bf16x8*)(KL + (16 * kt + fr) * 136 + ks * 32 + fq * 8); acc = MFMA16(a, bq[ks], acc); }
                LAS float* o = SSH + (16 * wid + fr) * 129 + 16 * kt + 4 * fq; o[0] = acc[0]; o[1] = acc[1]; o[2] = acc[2]; o[3] = acc[3];
            }
        }
        __syncthreads();
        {
            const int row = tid & 127, sub = tid >> 7;
            LAS float* rp = SSH + row * 129;
            int L[16], B[16];
#pragma unroll
            for (int i = 0; i < 16; ++i) { const int j = sub * 32 + i; L[i] = (fkey(rp[j]) & ~127) | (127 - j); }
            SORT16(L);
#pragma unroll
            for (int i = 0; i < 16; ++i) { const int j = sub * 32 + 16 + i; B[i] = (fkey(rp[j]) & ~127) | (127 - j); }
            SORT16(B);
            MERGE_PRUNE(L, B);
            if (sub >= 2) {
#pragma unroll
                for (int i = 0; i < 16; ++i) MG[tid * 17 + i] = L[i];
            }
            __syncthreads();
            if (sub < 2) {
#pragma unroll
                for (int i = 0; i < 16; ++i) B[i] = MG[(tid + 256) * 17 + i];
                MERGE_PRUNE(L, B);
                if (sub == 1) {
#pragma unroll
                    for (int i = 0; i < 16; ++i) MG[tid * 17 + i] = L[i];
                }
            }
            __syncthreads();
            if (sub == 0) {
#pragma unroll
                for (int i = 0; i < 16; ++i) B[i] = MG[(tid + 128) * 17 + i];
                MERGE_PRUNE(L, B);
#pragma unroll
                for (int i = 0; i < 16; ++i) { const int idx = 127 - (L[i] & 127); RR[row * 65 + ph * 32 + i] = rp[idx]; RR[row * 65 + ph * 32 + 16 + i] = __int_as_float(idx); }
            }
        }
        __syncthreads();
    }
    if (tid < 128) {
        const int tok = tid;
        LAS float* row = RR + tok * 65;
        float v1[16], v2[16];
#pragma unroll
        for (int i = 0; i < 16; ++i) { v1[i] = row[i]; v2[i] = row[32 + i]; }
        int L[16];
#pragma unroll
        for (int i = 0; i < 16; ++i) L[i] = (int)0x80000000;
#pragma unroll
        for (int a = 0; a < 16; ++a)
#pragma unroll
            for (int b = 0; b < 16; ++b) {
                if ((a + 1) * (b + 1) <= 16) {
                    int nk = (fkey(v1[a] + v2[b]) & ~255) | (255 - (a * 16 + b));
#pragma unroll
                    for (int i = 0; i < 16; ++i) { const int hi = max(L[i], nk); nk = min(L[i], nk); L[i] = hi; }
                }
            }
        float tv[16]; int ti[16]; float mx = -3.0e38f;
#pragma unroll
        for (int i = 0; i < 16; ++i) { const int ab = 255 - (L[i] & 255), a = ab >> 4, b = ab & 15;
            tv[i] = row[a] + row[32 + b]; ti[i] = __float_as_int(row[16 + a]) * 128 + __float_as_int(row[48 + b]); mx = fmaxf(mx, tv[i]); }
        float sum = 0.f;
#pragma unroll
        for (int i = 0; i < 16; ++i) { tv[i] = __expf(tv[i] - mx); sum += tv[i]; }
        const float inv = 1.f / sum;
        int* IDX = (int*)(p.ws + WS_IDX) + (size_t)(T0 + tok) * 128 + h * 16;
        float* GW = (float*)(p.ws + WS_GW) + (size_t)(T0 + tok) * 128 + h * 16;
#pragma unroll
        for (int i = 0; i < 4; ++i) {
            *(int4*)(IDX + 4 * i) = make_int4(ti[4 * i], ti[4 * i + 1], ti[4 * i + 2], ti[4 * i + 3]);
            *(f32x4*)(GW + 4 * i) = (f32x4){tv[4 * i] * inv, tv[4 * i + 1] * inv, tv[4 * i + 2] * inv, tv[4 * i + 3] * inv};
        }
    }
    __syncthreads();
}

typedef float f32x2 __attribute__((ext_vector_type(2)));
#define CVT4(W, B) __builtin_amdgcn_cvt_scalef32_pk_f32_fp4((W), 1.0f, (B))
__device__ __forceinline__ float dot16_fp4(const u32x2 w, const f32x2 (&hx)[8]) {
    f32x2 s = CVT4(w.x, 0) * hx[0];
    s += CVT4(w.x, 1) * hx[1]; s += CVT4(w.x, 2) * hx[2]; s += CVT4(w.x, 3) * hx[3];
    s += CVT4(w.y, 0) * hx[4]; s += CVT4(w.y, 1) * hx[5]; s += CVT4(w.y, 2) * hx[6]; s += CVT4(w.y, 3) * hx[7];
    return s[0] + s[1];
}
__device__ __forceinline__ void axpy16_fp4(const u32x2 w, const float a, f32x2 (&acc)[8]) {
    const f32x2 a2 = {a, a};
    acc[0] += a2 * CVT4(w.x, 0); acc[1] += a2 * CVT4(w.x, 1); acc[2] += a2 * CVT4(w.x, 2); acc[3] += a2 * CVT4(w.x, 3);
    acc[4] += a2 * CVT4(w.y, 0); acc[5] += a2 * CVT4(w.y, 1); acc[6] += a2 * CVT4(w.y, 2); acc[7] += a2 * CVT4(w.y, 3);
}
#define PEER_LOAD(UW, VW, GL, EB) do { _Pragma("unroll") for (int q = 0; q < 8; ++q) { const int e = (EB) + q; \
        const int ie = (e < 64) ? __builtin_amdgcn_readlane(myi0, e & 63) : __builtin_amdgcn_readlane(myi1, e & 63); \
        UW[q] = *(const u32x2*)(UTAB + (size_t)ie * 512 + lane * 8); VW[q] = *(const u32x2*)(VTAB + (size_t)ie * 512 + lane * 8); } \
        GL = GW[(EB) + (lane >> 3)]; } while (0)
#define PEER_COMPUTE(UW, VW, GL) do { float dt[8]; _Pragma("unroll") for (int q = 0; q < 8; ++q) dt[q] = dot16_fp4(UW[q], hx); \
        float r4[4]; _Pragma("unroll") for (int i = 0; i < 4; ++i) { const float mine = hi32 ? dt[i + 4] : dt[i], oth = hi32 ? dt[i] : dt[i + 4]; r4[i] = mine + __shfl_xor(oth, 32, 64); } \
        float r2[2]; _Pragma("unroll") for (int i = 0; i < 2; ++i) { const float mine = hi16 ? r4[i + 2] : r4[i], oth = hi16 ? r4[i] : r4[i + 2]; r2[i] = mine + __shfl_xor(oth, 16, 64); } \
        float r1; { const float mine = hi8 ? r2[1] : r2[0], oth = hi8 ? r2[0] : r2[1]; r1 = mine + __shfl_xor(oth, 8, 64); } \
        r1 += __shfl_xor(r1, 4, 64); r1 += __shfl_xor(r1, 2, 64); r1 += __shfl_xor(r1, 1, 64); \
        const float al = gelu_t(r1 * (1.f / U_SCALE)) * GL; \
        _Pragma("unroll") for (int q = 0; q < 8; ++q) { asm volatile("" : "+v"(VW[q]) : "v"(al)); \
            axpy16_fp4(VW[q], __int_as_float(__builtin_amdgcn_readlane(__float_as_int(al), q * 8)), acc); } } while (0)
__device__ void phase_peer(const Params& p) {
    const int tid_ = otid(), lane = tid_ & 63, wid = tid_ >> 6;
    const bool hi32 = (lane & 32) != 0, hi16 = (lane & 16) != 0, hi8 = (lane & 8) != 0;
    const unsigned char* UTAB = (const unsigned char*)(p.ws + WS_UTAB);
    const unsigned char* VTAB = (const unsigned char*)(p.ws + WS_VTAB);
    const float* fg = p.in[22];
    for (int tk = blockIdx.x * 8 + wid; tk < NTOK; tk += gridDim.x * 8) {
        const bf16_t* hrow = (const bf16_t*)(p.ws + WS_H) + (size_t)tk * 1024 + lane * 16;
        const u32x4 ha = *(const u32x4*)hrow, hb = *(const u32x4*)(hrow + 8);
        f32x2 hx[8];
        hx[0] = (f32x2){bflo(ha.x), bfhi(ha.x)}; hx[1] = (f32x2){bflo(ha.y), bfhi(ha.y)}; hx[2] = (f32x2){bflo(ha.z), bfhi(ha.z)}; hx[3] = (f32x2){bflo(ha.w), bfhi(ha.w)};
        hx[4] = (f32x2){bflo(hb.x), bfhi(hb.x)}; hx[5] = (f32x2){bflo(hb.y), bfhi(hb.y)}; hx[6] = (f32x2){bflo(hb.z), bfhi(hb.z)}; hx[7] = (f32x2){bflo(hb.w), bfhi(hb.w)};
        const int* IDX = (const int*)(p.ws + WS_IDX) + (size_t)tk * 128;
        const float* GW = (const float*)(p.ws + WS_GW) + (size_t)tk * 128;
        const int myi0 = IDX[lane], myi1 = IDX[64 + lane];
        f32x2 acc[8];
#pragma unroll
        for (int i = 0; i < 8; ++i) acc[i] = (f32x2){0.f, 0.f};
        u32x2 uA[8], vA[8], uB[8], vB[8], uC[8], vC[8]; float gA, gB, gC;
#define SB_ __builtin_amdgcn_sched_barrier(0)
        PEER_LOAD(uA, vA, gA, 0); PEER_LOAD(uB, vB, gB, 8); SB_;
        PEER_LOAD(uC, vC, gC, 16); SB_; PEER_COMPUTE(uA, vA, gA); SB_;
        PEER_LOAD(uA, vA, gA, 24); SB_; PEER_COMPUTE(uB, vB, gB); SB_;
        PEER_LOAD(uB, vB, gB, 32); SB_; PEER_COMPUTE(uC, vC, gC); SB_;
        PEER_LOAD(uC, vC, gC, 40); SB_; PEER_COMPUTE(uA, vA, gA); SB_;
        PEER_LOAD(uA, vA, gA, 48); SB_; PEER_COMPUTE(uB, vB, gB); SB_;
        PEER_LOAD(uB, vB, gB, 56); SB_; PEER_COMPUTE(uC, vC, gC); SB_;
        PEER_LOAD(uC, vC, gC, 64); SB_; PEER_COMPUTE(uA, vA, gA); SB_;
        PEER_LOAD(uA, vA, gA, 72); SB_; PEER_COMPUTE(uB, vB, gB); SB_;
        PEER_LOAD(uB, vB, gB, 80); SB_; PEER_COMPUTE(uC, vC, gC); SB_;
        PEER_LOAD(uC, vC, gC, 88); SB_; PEER_COMPUTE(uA, vA, gA); SB_;
        PEER_LOAD(uA, vA, gA, 96); SB_; PEER_COMPUTE(uB, vB, gB); SB_;
        PEER_LOAD(uB, vB, gB, 104); SB_; PEER_COMPUTE(uC, vC, gC); SB_;
        PEER_LOAD(uC, vC, gC, 112); SB_; PEER_COMPUTE(uA, vA, gA); SB_;
        PEER_LOAD(uA, vA, gA, 120); SB_; PEER_COMPUTE(uB, vB, gB); SB_;
        PEER_COMPUTE(uC, vC, gC); SB_;
        PEER_COMPUTE(uA, vA, gA); SB_;
#undef SB_
        const float* xr = (const float*)(p.ws + WS_X1) + (size_t)tk * 1024 + lane * 16;
        const float* g2 = (const float*)(p.ws + WS_MOD) + mod_of_token(tk) * 6144 + 5 * 1024 + lane * 16;
        float x2[16]; float ss = 0.f;
#pragma unroll
        for (int q = 0; q < 4; ++q) {
            const f32x4 xv = *(const f32x4*)(xr + q * 4), gv = *(const f32x4*)(g2 + q * 4);
#pragma unroll
            for (int j = 0; j < 4; ++j) { const float v = xv[j] + gv[j] * acc[q * 2 + (j >> 1)][j & 1] * (1.f / V_SCALE); x2[q * 4 + j] = v; ss += v * v; }
        }
        ss = wave_sum(ss);
        const float rstd = rsqrtf(ss * (1.f / 1024.f) + EPSN);
        float* yo = p.out + (size_t)tk * 1024 + lane * 16;
#pragma unroll
        for (int q = 0; q < 4; ++q) {
            const f32x4 fv = *(const f32x4*)(fg + lane * 16 + q * 4);
            f32x4 y;
#pragma unroll
            for (int j = 0; j < 4; ++j) y[j] = x2[q * 4 + j] * rstd * fv[j];
            *(f32x4*)(yo + q * 4) = y;
        }
    }
}

constexpr int N_PHASES = 13;
__global__ void __launch_bounds__(NTHREADS, 2) mega_fwd(Params p) {
    extern __shared__ __attribute__((aligned(16))) unsigned char smem[];
    LAS unsigned char* lds = (LAS unsigned char*)smem;
    cg::grid_group grid = cg::this_grid();
    if (p.ph_lo < 0) grid.sync();
    volatile LAS unsigned* xst = (volatile LAS unsigned*)(lds + LDS_BYTES - 16);
    if (threadIdx.x == 0) { xst[0] = 0u; xst[1] = 0u; xst[2] = 0u; xst[3] = 0u; }
    __syncthreads();
    XcdBarrier xb = xcd_barrier_post((unsigned*)(p.ws + WS_BAR), xst);
    for (int ph = p.ph_lo; ph < p.ph_hi; ++ph) {
        if (ph > p.ph_lo && ph != 7) xcd_barrier(xb);
#ifdef ONLY_PHASE
        if (ph != ONLY_PHASE) continue;
#endif
#ifdef REPEAT_MASK
        for (int rep = 0; rep < (((REPEAT_MASK) >> ph) & 1) + 1; ++rep) {
        if (rep) xcd_barrier(xb);
#endif
        int gm = -1, gN = 0, gK = 0, gsplit = 0; size_t offA = 0, offB = 0;
        switch (ph) {
        case 0: phase_prep(p, lds); break;
        case 1: phase_norm1(p); break;
        case 2: gm = 0; offA = WS_H; offB = WS_WINT; gN = INW; gK = 1024; break;
        case 3: phase_mix1(p, lds); break;
        case 4: phase_scan2(p, lds); break;
        case 5: if (gridDim.x == 256) {
                      S3Regs R; s3_load(p, blockIdx.x, 0, otid(), R);
                      scan3_item(p, lds, blockIdx.x, blockIdx.x + 256, R); scan3_item(p, lds, blockIdx.x + 256, -1, R);
                  } else { for (int it = blockIdx.x; it < 512; it += gridDim.x) { S3Regs R; s3_load(p, it, 0, otid(), R); scan3_item(p, lds, it, -1, R); } }
                  break;
        case 6: gm = 1; offA = WS_YA; offB = WS_WAT; gN = 1024; gK = 1024; break;
        case 7: break;
        case 8: gm = 3; offA = WS_PM; offB = WS_WOUTT; gN = 2048; gK = 512; gsplit = 4; break;
        case 9: phase_norm2(p); break;
        case 10: gm = 4; offA = WS_H; offB = WS_WQT; gN = 2048; gK = 1024; break;
        case 11: for (int it = blockIdx.x; it < 512; it += gridDim.x) topk_item(p, lds, it); break;
        case 12: phase_peer(p); break;
        }
        if (gridDim.x > 128 && blockIdx.x >= 128) {
            const int w = blockIdx.x - 128, nw = gridDim.x - 128;
            if (ph == 6) convert_tables(p, 0, 1024, w, nw);
        }
        if (gm >= 0) { EpiAll E; E.ws = p.ws; E.xp = p.in[0]; E.mode = gm; run_gemm(lds, (const bf16_t*)(p.ws + offA), (const bf16_t*)(p.ws + offB), NTOK, gN, gK, gsplit, (size_t)NTOK * 512 * 2, E); }
        if (ph == 2 && gridDim.x == 256 && blockIdx.x >= 192) transpose_all(p, (LAS float*)lds, 704, 1216, blockIdx.x - 192, 64);
#ifdef REPEAT_MASK
        }
#endif
    }
}

extern "C" void kernel_launch(void* const* d_in, const int* in_sizes, int n_in, void* d_out, int out_size, void* d_ws, size_t ws_size, hipStream_t stream) {
    static int grid = 0;
    if (grid == 0) {
        if (n_in != 23 || ws_size < WS_END) { fprintf(stderr, "kernel_launch: unexpected n_in %d / ws_size %zu (need %zu)\n", n_in, ws_size, (size_t)WS_END); grid = -1; return; }
        int dev = 0, cus = 0, per_cu = 0;
        hipGetDevice(&dev);
        hipDeviceGetAttribute(&cus, hipDeviceAttributeMultiprocessorCount, dev);
        if (hipFuncSetAttribute((const void*)mega_fwd, hipFuncAttributeMaxDynamicSharedMemorySize, LDS_BYTES) != hipSuccess) { fprintf(stderr, "kernel_launch: hipFuncSetAttribute failed\n"); grid = -1; return; }
        if (hipOccupancyMaxActiveBlocksPerMultiprocessor(&per_cu, (const void*)mega_fwd, NTHREADS, LDS_BYTES) != hipSuccess || per_cu < 1) { fprintf(stderr, "kernel_launch: occupancy query gave %d\n", per_cu); per_cu = 1; }
        (void)hipGetLastError();
        grid = cus * 1;
        fprintf(stderr, "kernel_launch: cus %d per_cu %d grid %d\n", cus, per_cu, grid);
    }
    if (grid < 0) return;
    Params p{};
    for (int i = 0; i < 23; ++i) p.in[i] = (const float*)d_in[i];
    p.out = (float*)d_out; p.ws = (unsigned char*)d_ws;
    if (hipMemsetAsync((char*)d_ws + WS_BAR, 0, XCD_BAR_WORDS * 4, stream) != hipSuccess) { fprintf(stderr, "kernel_launch: memset of the barrier words failed\n"); return; }
#if N_LAUNCH_MODE == 0
    p.ph_lo = 0; p.ph_hi = N_PHASES;
    void* args[] = {&p};
    hipError_t e = hipLaunchCooperativeKernel((const void*)mega_fwd, dim3(grid), dim3(NTHREADS), args, LDS_BYTES, stream);
    if (e != hipSuccess) fprintf(stderr, "cooperative launch failed: %s (grid %d)\n", hipGetErrorString(e), grid);
#else
    for (int ph = 0; ph < N_PHASES; ++ph) {
        p.ph_lo = ph; p.ph_hi = ph + 1;
        hipLaunchKernelGGL(mega_fwd, dim3(grid), dim3(NTHREADS), LDS_BYTES, stream, p);
    }
#endif
}
```
